# Optimizing an MI355X kernel written in HIP

```python
import math
import jax, jax.numpy as jnp
from jax import lax
import numpy as np

D_MODEL = 1024
BATCH = 8
SEQ = 4096
DEPTH = 2

N_EVEN = (DEPTH + 1) // 2
N_ODD = DEPTH // 2
DN_ALPHA = (2.0 * DEPTH) ** 0.25
DN_BETA = (8.0 * DEPTH) ** -0.25

RNN_WIDTH = D_MODEL // 2
RNN_HEADS = 8
RNN_HEAD_DIM = RNN_WIDTH // RNN_HEADS
CONV_WIDTH = 4
RG_C = 8.0

MLA_HEADS = 8
MLA_NOPE = 64
MLA_ROPE = 32
MLA_V = 64
MLA_Q_RANK = D_MODEL // 4
MLA_KV_RANK = D_MODEL // 8
MLA_WIDTH = MLA_HEADS * MLA_V
ROPE_THETA = 10000.0
Q_BLOCK = 128

AB_WIDTH = RNN_WIDTH + MLA_WIDTH
AB_IN = RNN_WIDTH + AB_WIDTH + MLA_Q_RANK + MLA_KV_RANK + MLA_ROPE

SSD_INNER = 2 * D_MODEL
SSD_HEAD_DIM = 64
SSD_HEADS = SSD_INNER // SSD_HEAD_DIM
SSD_GROUPS = 4
SSD_STATE = 128
SSD_CHUNK = 128
SSD_CONV_DIM = SSD_INNER + 2 * SSD_GROUPS * SSD_STATE
SSD_IN = SSD_INNER + SSD_CONV_DIM + SSD_HEADS

kernel_name = "hybrid_rglru_mla_ssd_deepnorm"


def _rmsnorm(x, g, eps=1e-6):
    xf = x.astype(jnp.float32)
    y = xf * lax.rsqrt(jnp.mean(xf * xf, axis=-1, keepdims=True) + eps)
    return (y * g.astype(jnp.float32)).astype(x.dtype)


def _layernorm(x, g, b, eps=1e-5):
    xf = x.astype(jnp.float32)
    mu = jnp.mean(xf, axis=-1, keepdims=True)
    xc = xf - mu
    var = jnp.mean(xc * xc, axis=-1, keepdims=True)
    y = xc * lax.rsqrt(var + eps) * g.astype(jnp.float32) + b.astype(jnp.float32)
    return y.astype(x.dtype)


def _causal_conv(x, w, b):
    k_taps = w.shape[0]
    seqlen = x.shape[1]
    xp = jnp.pad(x, ((0, 0), (k_taps - 1, 0), (0, 0)))
    return sum(xp[:, k:k + seqlen] * w[k] for k in range(k_taps)) + b


def _rope(x, cos, sin):
    half = x.shape[-1] // 2
    x1, x2 = x[..., :half], x[..., half:]
    return jnp.concatenate([x1 * cos - x2 * sin, x2 * cos + x1 * sin], axis=-1)


def _rg_lru(x, w_a, b_a, w_x, b_x, lam):
    bsz, seqlen, _ = x.shape
    xh = x.reshape(bsz, seqlen, RNN_HEADS, RNN_HEAD_DIM)
    r = jax.nn.sigmoid(jnp.einsum('bshi,hij->bshj', xh, w_a).reshape(bsz, seqlen, RNN_WIDTH) + b_a)
    i = jax.nn.sigmoid(jnp.einsum('bshi,hij->bshj', xh, w_x).reshape(bsz, seqlen, RNN_WIDTH) + b_x)
    log_a = (-RG_C * r.astype(jnp.float32)) * jax.nn.softplus(-lam.astype(jnp.float32))
    a = jnp.exp(log_a)
    mult = jnp.sqrt(-jnp.expm1(2.0 * log_a))
    u = mult * (i * x).astype(jnp.float32)

    def combine(c1, c2):
        a1, b1 = c1
        a2, b2 = c2
        return a1 * a2, a2 * b1 + b2

    _, h = lax.associative_scan(combine, (a, u), axis=1)
    return h.astype(x.dtype)


def _mla_attention(q_nope, q_rope, k_nope, k_rope, v):
    seqlen = q_nope.shape[1]
    scale = (MLA_NOPE + MLA_ROPE) ** -0.5
    outs = []
    for blk in range(seqlen // Q_BLOCK):
        q0 = blk * Q_BLOCK
        kend = q0 + Q_BLOCK
        s = (jnp.einsum('bqhd,bkhd->bhqk', q_nope[:, q0:kend], k_nope[:, :kend])
             + jnp.einsum('bqhr,bkr->bhqk', q_rope[:, q0:kend], k_rope[:, :kend]))
        s = s.astype(jnp.float32) * scale
        mask = jnp.arange(kend)[None, :] <= (q0 + jnp.arange(Q_BLOCK))[:, None]
        s = jnp.where(mask, s, -jnp.inf)
        p = jax.nn.softmax(s, axis=-1).astype(v.dtype)
        outs.append(jnp.einsum('bhqk,bkhd->bqhd', p, v[:, :kend]))
    return jnp.concatenate(outs, axis=1)


def _rglru_mla_layer(x, cos, sin, w_in, conv_w, conv_b, gate_a_w, gate_a_b, gate_x_w,
                     gate_x_b, lam, q_norm, kv_norm, w_uq, w_ukv, w_out):
    bsz, seqlen, _ = x.shape
    proj = jnp.einsum('bsd,de->bse', x, w_in)
    x_rnn, gate, c_q, c_kv, k_rope = jnp.split(
        proj, [RNN_WIDTH, RNN_WIDTH + AB_WIDTH, RNN_WIDTH + AB_WIDTH + MLA_Q_RANK,
               RNN_WIDTH + AB_WIDTH + MLA_Q_RANK + MLA_KV_RANK], axis=-1)
    x_rnn = _causal_conv(x_rnn, conv_w, conv_b)
    y_rnn = _rg_lru(x_rnn, gate_a_w, gate_a_b, gate_x_w, gate_x_b, lam)
    q = jnp.einsum('bsr,re->bse', _rmsnorm(c_q, q_norm), w_uq)
    q = q.reshape(bsz, seqlen, MLA_HEADS, MLA_NOPE + MLA_ROPE)
    q_nope = q[..., :MLA_NOPE]
    q_rope = _rope(q[..., MLA_NOPE:], cos[:, :, None], sin[:, :, None])
    kv = jnp.einsum('bsr,re->bse', _rmsnorm(c_kv, kv_norm), w_ukv)
    kv = kv.reshape(bsz, seqlen, MLA_HEADS, MLA_NOPE + MLA_V)
    k_nope, v = kv[..., :MLA_NOPE], kv[..., MLA_NOPE:]
    k_rope = _rope(k_rope, cos, sin)
    y_mla = _mla_attention(q_nope, q_rope, k_nope, k_rope, v).reshape(bsz, seqlen, MLA_WIDTH)
    y = jnp.concatenate([y_rnn, y_mla], axis=-1) * jax.nn.silu(gate)
    return jnp.einsum('bse,ed->bsd', y, w_out)


def _ssd_scan(x, dt, a_neg, bm, cm):
    bsz, seqlen, n_heads, p_dim = x.shape
    n_groups, n_state = bm.shape[2], bm.shape[3]
    hpg = n_heads // n_groups
    nc, L = seqlen // SSD_CHUNK, SSD_CHUNK
    xf = (x.astype(jnp.float32) * dt[..., None]).reshape(bsz, nc, L, n_groups, hpg, p_dim)
    a_dt = (dt * a_neg).reshape(bsz, nc, L, n_groups, hpg)
    bc = bm.astype(jnp.float32).reshape(bsz, nc, L, n_groups, n_state)
    cc = cm.astype(jnp.float32).reshape(bsz, nc, L, n_groups, n_state)
    cs = jnp.cumsum(a_dt, axis=2)
    cs_h = jnp.transpose(cs, (0, 1, 3, 4, 2))
    seg = cs_h[..., :, None] - cs_h[..., None, :]
    causal = jnp.tril(jnp.ones((L, L), dtype=bool))
    decay = jnp.where(causal, jnp.exp(jnp.where(causal, seg, 0.0)), 0.0)
    cb = jnp.einsum('bclgn,bcsgn->bcgls', cc, bc)
    y_diag = jnp.einsum('bcghls,bcsghp->bclghp', cb[:, :, :, None] * decay, xf)
    decay_states = jnp.exp(cs[:, :, -1:] - cs)
    states = jnp.einsum('bclgn,bclghp->bcghpn', bc, xf * decay_states[..., None])
    chunk_decay = jnp.exp(cs[:, :, -1])

    def step(h, inp):
        dec, st = inp
        return h * dec[..., None, None] + st, h

    h0 = jnp.zeros((bsz, n_groups, hpg, p_dim, n_state), jnp.float32)
    _, prev = lax.scan(step, h0, (jnp.moveaxis(chunk_decay, 1, 0), jnp.moveaxis(states, 1, 0)))
    prev = jnp.moveaxis(prev, 0, 1)
    y_off = jnp.einsum('bclgn,bcghpn->bclghp', cc, prev) * jnp.exp(cs)[..., None]
    return (y_diag + y_off).reshape(bsz, seqlen, n_heads, p_dim)


def _ssd_layer(x, w_in, conv_w, conv_b, dt_bias, a_log, d_skip, norm_w, w_out):
    bsz, seqlen, _ = x.shape
    proj = jnp.einsum('bsd,de->bse', x, w_in)
    z, xbc, dt = jnp.split(proj, [SSD_INNER, SSD_INNER + SSD_CONV_DIM], axis=-1)
    xbc = jax.nn.silu(_causal_conv(xbc, conv_w, conv_b))
    xs, bm, cm = jnp.split(xbc, [SSD_INNER, SSD_INNER + SSD_GROUPS * SSD_STATE], axis=-1)
    xs = xs.reshape(bsz, seqlen, SSD_HEADS, SSD_HEAD_DIM)
    bm = bm.reshape(bsz, seqlen, SSD_GROUPS, SSD_STATE)
    cm = cm.reshape(bsz, seqlen, SSD_GROUPS, SSD_STATE)
    dt = jax.nn.softplus(dt.astype(jnp.float32) + dt_bias.astype(jnp.float32))
    a_neg = -jnp.exp(a_log.astype(jnp.float32))
    y = _ssd_scan(xs, dt, a_neg, bm, cm) + d_skip.astype(jnp.float32)[:, None] * xs.astype(jnp.float32)
    y = y.reshape(bsz, seqlen, SSD_INNER) * jax.nn.silu(z.astype(jnp.float32))
    yg = y.reshape(bsz, seqlen, SSD_GROUPS, SSD_INNER // SSD_GROUPS)
    yg = yg * lax.rsqrt(jnp.mean(yg * yg, axis=-1, keepdims=True) + 1e-6)
    y = (yg.reshape(bsz, seqlen, SSD_INNER) * norm_w.astype(jnp.float32)).astype(x.dtype)
    return jnp.einsum('bse,ed->bsd', y, w_out)


def setup_inputs(seed: int = 0) -> dict:
    key = jax.random.key(seed)
    ks = jax.random.split(key, 32)
    f32 = jnp.float32
    nrm = lambda k, shape, s: jax.random.normal(k, shape, f32) * s

    x = jax.random.normal(ks[0], (BATCH, SEQ, D_MODEL), f32)
    offset = jax.random.randint(ks[1], (BATCH, 1), 0, 1024, dtype=jnp.int32)
    positions = offset + jnp.arange(SEQ, dtype=jnp.int32)[None, :]

    ab_w_in = nrm(ks[2], (N_EVEN, D_MODEL, AB_IN), D_MODEL ** -0.5)
    ab_conv_w = nrm(ks[3], (N_EVEN, CONV_WIDTH, RNN_WIDTH), CONV_WIDTH ** -0.5)
    ab_conv_b = nrm(ks[4], (N_EVEN, RNN_WIDTH), 0.02)
    ab_gate_a_w = nrm(ks[5], (N_EVEN, RNN_HEADS, RNN_HEAD_DIM, RNN_HEAD_DIM), RNN_HEAD_DIM ** -0.5)
    ab_gate_a_b = nrm(ks[6], (N_EVEN, RNN_WIDTH), 0.1)
    ab_gate_x_w = nrm(ks[7], (N_EVEN, RNN_HEADS, RNN_HEAD_DIM, RNN_HEAD_DIM), RNN_HEAD_DIM ** -0.5)
    ab_gate_x_b = nrm(ks[8], (N_EVEN, RNN_WIDTH), 0.1)
    u = jax.random.uniform(ks[9], (N_EVEN, RNN_WIDTH), f32, 0.9, 0.999)
    a0 = u ** (1.0 / RG_C)
    ab_lambda = jnp.log(a0) - jnp.log1p(-a0)
    mla_q_norm = 1.0 + nrm(ks[10], (N_EVEN, MLA_Q_RANK), 0.05)
    mla_kv_norm = 1.0 + nrm(ks[11], (N_EVEN, MLA_KV_RANK), 0.05)
    mla_w_uq = nrm(ks[12], (N_EVEN, MLA_Q_RANK, MLA_HEADS * (MLA_NOPE + MLA_ROPE)), MLA_Q_RANK ** -0.5)
    mla_w_ukv = nrm(ks[13], (N_EVEN, MLA_KV_RANK, MLA_HEADS * (MLA_NOPE + MLA_V)), MLA_KV_RANK ** -0.5)
    ab_w_out = nrm(ks[14], (N_EVEN, AB_WIDTH, D_MODEL), DN_BETA * math.sqrt(2.0 / (AB_WIDTH + D_MODEL)))
    ab_ln_g = 1.0 + nrm(ks[15], (N_EVEN, D_MODEL), 0.05)
    ab_ln_b = nrm(ks[16], (N_EVEN, D_MODEL), 0.02)

    ssd_w_in = nrm(ks[17], (N_ODD, D_MODEL, SSD_IN), D_MODEL ** -0.5)
    ssd_conv_w = nrm(ks[18], (N_ODD, CONV_WIDTH, SSD_CONV_DIM), CONV_WIDTH ** -0.5)
    ssd_conv_b = nrm(ks[19], (N_ODD, SSD_CONV_DIM), 0.02)
    dt0 = jnp.exp(jax.random.uniform(ks[20], (N_ODD, SSD_HEADS), f32, math.log(1e-3), math.log(1e-1)))
    ssd_dt_bias = dt0 + jnp.log(-jnp.expm1(-dt0))
    ssd_a_log = jnp.log(jax.random.uniform(ks[21], (N_ODD, SSD_HEADS), f32, 1.0, 16.0))
    ssd_d = 1.0 + nrm(ks[22], (N_ODD, SSD_HEADS), 0.1)
    ssd_norm = 1.0 + nrm(ks[23], (N_ODD, SSD_INNER), 0.05)
    ssd_w_out = nrm(ks[24], (N_ODD, SSD_INNER, D_MODEL), DN_BETA * math.sqrt(2.0 / (SSD_INNER + D_MODEL)))
    ssd_ln_g = 1.0 + nrm(ks[25], (N_ODD, D_MODEL), 0.05)
    ssd_ln_b = nrm(ks[26], (N_ODD, D_MODEL), 0.02)

    return {"x": x, "positions": positions,
            "ab_w_in": ab_w_in, "ab_conv_w": ab_conv_w, "ab_conv_b": ab_conv_b,
            "ab_gate_a_w": ab_gate_a_w, "ab_gate_a_b": ab_gate_a_b,
            "ab_gate_x_w": ab_gate_x_w, "ab_gate_x_b": ab_gate_x_b,
            "ab_lambda": ab_lambda, "mla_q_norm": mla_q_norm, "mla_kv_norm": mla_kv_norm,
            "mla_w_uq": mla_w_uq, "mla_w_ukv": mla_w_ukv, "ab_w_out": ab_w_out,
            "ab_ln_g": ab_ln_g, "ab_ln_b": ab_ln_b,
            "ssd_w_in": ssd_w_in, "ssd_conv_w": ssd_conv_w, "ssd_conv_b": ssd_conv_b,
            "ssd_dt_bias": ssd_dt_bias, "ssd_a_log": ssd_a_log, "ssd_d": ssd_d,
            "ssd_norm": ssd_norm, "ssd_w_out": ssd_w_out,
            "ssd_ln_g": ssd_ln_g, "ssd_ln_b": ssd_ln_b}


def reference(x, positions, ab_w_in, ab_conv_w, ab_conv_b, ab_gate_a_w, ab_gate_a_b,
              ab_gate_x_w, ab_gate_x_b, ab_lambda, mla_q_norm, mla_kv_norm, mla_w_uq,
              mla_w_ukv, ab_w_out, ab_ln_g, ab_ln_b, ssd_w_in, ssd_conv_w, ssd_conv_b,
              ssd_dt_bias, ssd_a_log, ssd_d, ssd_norm, ssd_w_out, ssd_ln_g, ssd_ln_b):
    inv_freq = ROPE_THETA ** (-jnp.arange(0, MLA_ROPE, 2, dtype=jnp.float32) / MLA_ROPE)
    ang = positions.astype(jnp.float32)[..., None] * inv_freq
    cos = jnp.cos(ang).astype(x.dtype)
    sin = jnp.sin(ang).astype(x.dtype)
    for layer in range(DEPTH):
        j = layer // 2
        if layer % 2 == 0:
            y = _rglru_mla_layer(x, cos, sin, ab_w_in[j], ab_conv_w[j], ab_conv_b[j],
                                 ab_gate_a_w[j], ab_gate_a_b[j], ab_gate_x_w[j], ab_gate_x_b[j],
                                 ab_lambda[j], mla_q_norm[j], mla_kv_norm[j], mla_w_uq[j],
                                 mla_w_ukv[j], ab_w_out[j])
            x = _layernorm(DN_ALPHA * x + y, ab_ln_g[j], ab_ln_b[j])
        else:
            y = _ssd_layer(x, ssd_w_in[j], ssd_conv_w[j], ssd_conv_b[j], ssd_dt_bias[j],
                           ssd_a_log[j], ssd_d[j], ssd_norm[j], ssd_w_out[j])
            x = _layernorm(DN_ALPHA * x + y, ssd_ln_g[j], ssd_ln_b[j])
    return x
```

```cpp
#include <hip/hip_runtime.h>
#include <hip/hip_cooperative_groups.h>
#include <cstdio>
namespace cg = cooperative_groups;

typedef unsigned short u16;
typedef short bf16x8 __attribute__((ext_vector_type(8)));
typedef short s16x4 __attribute__((ext_vector_type(4)));
typedef float f32x16 __attribute__((ext_vector_type(16)));
typedef float f32x4 __attribute__((ext_vector_type(4)));
typedef unsigned u32x4 __attribute__((ext_vector_type(4)));
typedef unsigned u32x2 __attribute__((ext_vector_type(2)));
typedef __bf16 bf2_t __attribute__((ext_vector_type(2)));

#define DI __device__ __forceinline__
#define NT 512
#define MFMA32(a, b, c) __builtin_amdgcn_mfma_f32_32x32x16_bf16((a), (b), (c), 0, 0, 0)

constexpr int T = 32768, SEQ = 4096;
constexpr float DN_ALPHA = 1.41421356237309515f;
constexpr size_t Mi = 1024ull * 1024ull;
constexpr size_t OFF_W1T = 0, OFF_WOT = 4 * Mi, OFF_W2T = 6 * Mi, OFF_W3T = 16 * Mi + 512 * 1024, OFF_WQT = 20 * Mi + 512 * 1024,
                 OFF_WKVT = 21 * Mi, OFF_WAT = 21 * Mi + 256 * 1024, OFF_WXT = 21 * Mi + 320 * 1024, OFF_COS = 21 * Mi + 512 * 1024,
                 OFF_SIN = 23 * Mi + 512 * 1024, OFF_HEND = 25 * Mi + 512 * 1024, OFF_PEND = 26 * Mi, OFF_SS = 26 * Mi + 512 * 1024,
                 OFF_DT = 27 * Mi, OFF_XB = 32 * Mi, OFF_YCAT = 32 * Mi, OFF_X1B = 32 * Mi, OFF_BC = 32 * Mi, OFF_PROJ0 = 96 * Mi,
                 OFF_HLOC = 224 * Mi, OFF_PCUM = 256 * Mi, OFF_Q = 288 * Mi, OFF_KC = 336 * Mi, OFF_VT = 384 * Mi, OFF_PROJ1 = 96 * Mi;
constexpr int LD0 = 2048, LD1 = 5248;

struct Params {
  const float* x; const int* pos;
  const float *ab_w_in, *ab_conv_w, *ab_conv_b, *ga_w, *ga_b, *gx_w, *gx_b, *lam, *qn, *kvn, *w_uq, *w_ukv, *ab_w_out, *ab_ln_g, *ab_ln_b;
  const float *ssd_w_in, *ssd_conv_w, *ssd_conv_b, *dt_bias, *a_log, *ssd_d, *ssd_norm, *ssd_w_out, *ssd_ln_g, *ssd_ln_b;
  float* out; char* ws;
};

DI unsigned pk2(float a, float b) { bf2_t v; v[0] = (__bf16)a; v[1] = (__bf16)b; return __builtin_bit_cast(unsigned, v); }
DI u16 f2bf(float a) { __bf16 v = (__bf16)a; return __builtin_bit_cast(u16, v); }
DI float bflo(unsigned w) { return __uint_as_float(w << 16); }
DI float bfhi(unsigned w) { return __uint_as_float(w & 0xffff0000u); }
DI float bf2f(u16 v) { return __uint_as_float(((unsigned)v) << 16); }
DI float fast_exp2(float x) { return __builtin_amdgcn_exp2f(x); }
DI float fast_exp(float x) { return __builtin_amdgcn_exp2f(x * 1.44269504088896341f); }
DI float fast_rcp(float x) { return __builtin_amdgcn_rcpf(x); }
DI float sigmoidf_(float x) { return fast_rcp(1.0f + fast_exp(-x)); }
DI float siluf_(float x) { return x * sigmoidf_(x); }
DI int crow(int i, int h) { return (i & 3) + 8 * (i >> 2) + 4 * h; }
DI void unpack8(const u32x4& v, float* f) {
  f[0] = bflo(v.x); f[1] = bfhi(v.x); f[2] = bflo(v.y); f[3] = bfhi(v.y); f[4] = bflo(v.z); f[5] = bfhi(v.z); f[6] = bflo(v.w); f[7] = bfhi(v.w);
}
DI u32x4 pack8(const float* f) { u32x4 v; v.x = pk2(f[0], f[1]); v.y = pk2(f[2], f[3]); v.z = pk2(f[4], f[5]); v.w = pk2(f[6], f[7]); return v; }
DI bf16x8 pack_frag(const f32x16& x, int s) {
  u32x4 v; v.x = pk2(x[8 * s], x[8 * s + 1]); v.y = pk2(x[8 * s + 2], x[8 * s + 3]); v.z = pk2(x[8 * s + 4], x[8 * s + 5]); v.w = pk2(x[8 * s + 6], x[8 * s + 7]);
  return __builtin_bit_cast(bf16x8, v);
}
DI bf16x8 ld_frag16(const u16* p) { return *(const bf16x8*)p; }
DI bf16x8 ld_frag8x2(const u16* p0, const u16* p1) {
  s16x4 lo = *(const s16x4*)p0, hi = *(const s16x4*)p1;
  return __builtin_shufflevector(lo, hi, 0, 1, 2, 3, 4, 5, 6, 7);
}

DI void tr_tile(const float* __restrict__ src, u16* __restrict__ dst, int K, int N, const float* __restrict__ scale, int kt, int nt, char* smem) {
  float* tf = (float*)smem;
  const int tid = threadIdx.x, k0 = kt * 64, n0 = nt * 64;
#pragma unroll
  for (int i = 0; i < 8; ++i) {
    const int kk = (tid >> 6) + 8 * i, nn = tid & 63;
    float v = 0.f;
    if (n0 + nn < N) { v = src[(size_t)(k0 + kk) * N + n0 + nn]; if (scale) v *= scale[k0 + kk]; }
    tf[kk * 65 + nn] = v;
  }
  __syncthreads();
#pragma unroll
  for (int i = 0; i < 8; ++i) {
    const int nn = (tid >> 6) + 8 * i, kk = tid & 63;
    dst[(size_t)(n0 + nn) * K + k0 + kk] = f2bf(tf[kk * 65 + nn]);
  }
  __syncthreads();
}
DI void tr_job(const float* src, u16* dst, int K, int N, int Npad, const float* scale, int& rot, char* smem) {
  const int nkt = K / 64, nnt = Npad / 64, n = nkt * nnt, nb = gridDim.x;
  for (int it = (blockIdx.x + nb - rot) % nb; it < n; it += nb) tr_tile(src, dst, K, N, scale, it % nkt, it / nkt, smem);
  rot = (rot + n) % nb;
}

DI void phase_prep(const Params& p, char* smem) {
  char* ws = p.ws;
  int rot = 0;
  tr_job(p.ab_w_in, (u16*)(ws + OFF_W1T), 1024, 1952, 2048, nullptr, rot, smem);
  tr_job(p.ssd_w_in, (u16*)(ws + OFF_W2T), 1024, 5152, 5248, nullptr, rot, smem);
  tr_job(p.ab_w_out, (u16*)(ws + OFF_WOT), 1024, 1024, 1024, nullptr, rot, smem);
  tr_job(p.ssd_w_out, (u16*)(ws + OFF_W3T), 2048, 1024, 1024, p.ssd_norm, rot, smem);
  tr_job(p.w_uq, (u16*)(ws + OFF_WQT), 256, 768, 768, p.qn, rot, smem);
  tr_job(p.w_ukv, (u16*)(ws + OFF_WKVT), 128, 1024, 1024, p.kvn, rot, smem);
  for (int hd = 0; hd < 8; ++hd) {
    tr_job(p.ga_w + hd * 4096, (u16*)(ws + OFF_WAT) + hd * 4096, 64, 64, 64, nullptr, rot, smem);
    tr_job(p.gx_w + hd * 4096, (u16*)(ws + OFF_WXT) + hd * 4096, 64, 64, 64, nullptr, rot, smem);
  }
  const size_t gid = (size_t)blockIdx.x * NT + threadIdx.x, gstride = (size_t)gridDim.x * NT;
  {
    const f32x4* xs = (const f32x4*)p.x; u32x4* xb = (u32x4*)(ws + OFF_XB);
    const size_t n8 = (size_t)T * 1024 / 8;
    for (size_t i = gid; i < n8; i += gstride) {
      const f32x4 a = xs[2 * i], b = xs[2 * i + 1];
      u32x4 o; o.x = pk2(a.x, a.y); o.y = pk2(a.z, a.w); o.z = pk2(b.x, b.y); o.w = pk2(b.z, b.w);
      xb[i] = o;
    }
  }
  {
    float* ct = (float*)(ws + OFF_COS); float* st = (float*)(ws + OFF_SIN);
    for (size_t i = gid; i < (size_t)T * 16; i += gstride) {
      const int t = (int)(i >> 4), j = (int)(i & 15);
      const float inv = exp2f(-(float)j * (13.287712379549449f / 16.0f));
      const float ang = (float)p.pos[t] * inv;
      const double rev = (double)ang * 0.15915494309189535;
      const double fr = rev - rint(rev);
      const float a = (float)(fr * 6.283185307179586);
      ct[i] = cosf(a); st[i] = sinf(a);
    }
  }
  {
    float* ss = (float*)(ws + OFF_SS);
    for (size_t i = gid; i < (size_t)T * 4; i += gstride) ss[i] = 0.f;
  }
}

constexpr int GA_ST = 72;
constexpr float QSCALE = 0.10206207261596575f * 1.44269504088896341f;

template <int MODE>
DI void gemm_epi(const Params& p, int row, int colbase, int h, const f32x16& v, float rs) {
  char* ws = p.ws;
  if constexpr (MODE == 1) {
    u16* dst = (u16*)(ws + OFF_PROJ0) + (size_t)row * LD0;
#pragma unroll
    for (int g = 0; g < 4; ++g) {
      const int col = colbase + 8 * g + 4 * h;
      float a = v[4 * g], b = v[4 * g + 1], c = v[4 * g + 2], d = v[4 * g + 3];
      if (col >= 512 && col < 1536) { a = siluf_(a); b = siluf_(b); c = siluf_(c); d = siluf_(d); }
      u32x2 o; o.x = pk2(a, b); o.y = pk2(c, d);
      *(u32x2*)(dst + col) = o;
    }
  } else if constexpr (MODE == 2) {
    u16* dst = (u16*)(ws + OFF_Q) + (size_t)row * 768;
    f32x16 o;
    if ((colbase % 96) == 64) {
      const float* ct = (const float*)(ws + OFF_COS) + (size_t)row * 16;
      const float* st = (const float*)(ws + OFF_SIN) + (size_t)row * 16;
#pragma unroll
      for (int i = 0; i < 8; ++i) {
        const int idx = crow(i, h);
        const float c = ct[idx], s = st[idx], x1 = v[i] * rs, x2 = v[i + 8] * rs;
        o[i] = (x1 * c - x2 * s) * QSCALE; o[i + 8] = (x2 * c + x1 * s) * QSCALE;
      }
    } else {
#pragma unroll
      for (int i = 0; i < 16; ++i) o[i] = v[i] * (rs * QSCALE);
    }
#pragma unroll
    for (int g = 0; g < 4; ++g) {
      u32x2 w; w.x = pk2(o[4 * g], o[4 * g + 1]); w.y = pk2(o[4 * g + 2], o[4 * g + 3]);
      *(u32x2*)(dst + colbase + 8 * g + 4 * h) = w;
    }
  } else if constexpr (MODE == 3) {
    const int hd = colbase >> 7, within = colbase & 127;
    if (within < 64) {
      u16* dst = (u16*)(ws + OFF_KC) + (size_t)row * 768 + hd * 96 + within;
#pragma unroll
      for (int g = 0; g < 4; ++g) {
        u32x2 w; w.x = pk2(v[4 * g] * rs, v[4 * g + 1] * rs); w.y = pk2(v[4 * g + 2] * rs, v[4 * g + 3] * rs);
        *(u32x2*)(dst + 8 * g + 4 * h) = w;
      }
    } else {
      const int b = row >> 12, s = row & 4095;
      u16* dst = (u16*)(ws + OFF_VT) + ((size_t)(b * 8 + hd) * 64 + (within - 64)) * SEQ + s;
#pragma unroll
      for (int i = 0; i < 16; ++i) dst[(size_t)crow(i, h) * SEQ] = f2bf(v[i] * rs);
    }
  } else if constexpr (MODE == 4 || MODE == 6) {
    const float* src = (MODE == 4) ? p.x : p.out;
#pragma unroll
    for (int g = 0; g < 4; ++g) {
      const size_t off = (size_t)row * 1024 + colbase + 8 * g + 4 * h;
      const f32x4 xv = *(const f32x4*)(src + off);
      f32x4 o; o.x = DN_ALPHA * xv.x + v[4 * g]; o.y = DN_ALPHA * xv.y + v[4 * g + 1]; o.z = DN_ALPHA * xv.z + v[4 * g + 2]; o.w = DN_ALPHA * xv.w + v[4 * g + 3];
      *(f32x4*)(p.out + off) = o;
    }
  } else if constexpr (MODE == 5) {
    if (colbase < 5120) {
      u16* dst = (u16*)(ws + OFF_PROJ1) + (size_t)row * LD1;
#pragma unroll
      for (int g = 0; g < 4; ++g) {
        const int col = colbase + 8 * g + 4 * h;
        float a = v[4 * g], b = v[4 * g + 1], c = v[4 * g + 2], d = v[4 * g + 3];
        if (col < 2048) { a = siluf_(a); b = siluf_(b); c = siluf_(c); d = siluf_(d); }
        u32x2 o; o.x = pk2(a, b); o.y = pk2(c, d);
        *(u32x2*)(dst + col) = o;
      }
    } else if (colbase == 5120) {
      float* dst = (float*)(ws + OFF_DT) + (size_t)row * 32;
#pragma unroll
      for (int i = 0; i < 16; ++i) {
        const int c = crow(i, h);
        const float xv = v[i] + p.dt_bias[c];
        dst[c] = fmaxf(xv, 0.f) + log1pf(expf(-fabsf(xv)));
      }
    }
  }
}

template <int MODE>
DI void gemm_tile(const Params& p, const u16* __restrict__ A, int lda, const u16* __restrict__ Bt, int K, int m0, int n0, char* smem) {
  constexpr bool ROWNORM = (MODE == 2 || MODE == 3);
  constexpr bool GROUPS = (MODE == 6);
  u16* As = (u16*)smem;
  u16* Bs = (u16*)(smem + 2 * 256 * GA_ST * 2);
  float* ssrow = (float*)(smem + 2 * 256 * GA_ST * 2 + 2 * 128 * GA_ST * 2);
  const int tid = threadIdx.x, lane = tid & 63, w = tid >> 6, wm = w & 3, wn = w >> 2, r = lane & 31, h = lane >> 5;
  const int lrow = tid >> 3, lkc = (tid & 7) * 8;
  const u16* ag = A + (size_t)(m0 + lrow) * lda + lkc;
  const u16* bg = Bt + (size_t)(n0 + lrow) * K + lkc;
  u32x4 ra[4], rb[2];
  float ssq[4] = {0.f, 0.f, 0.f, 0.f};
  f32x16 acc[2][2];
#pragma unroll
  for (int i = 0; i < 2; ++i)
#pragma unroll
    for (int j = 0; j < 2; ++j)
#pragma unroll
      for (int e = 0; e < 16; ++e) acc[i][j][e] = 0.f;
  const int nk = K / 64;
  auto gload = [&](int kt) {
#pragma unroll
    for (int i = 0; i < 4; ++i) ra[i] = *(const u32x4*)(ag + (size_t)(64 * i) * lda + kt * 64);
#pragma unroll
    for (int i = 0; i < 2; ++i) rb[i] = *(const u32x4*)(bg + (size_t)(64 * i) * K + kt * 64);
  };
  auto lstore = [&](int buf) {
    u16* as = As + buf * 256 * GA_ST; u16* bs = Bs + buf * 128 * GA_ST;
#pragma unroll
    for (int i = 0; i < 4; ++i) {
      *(u32x4*)(as + (lrow + 64 * i) * GA_ST + lkc) = ra[i];
      if constexpr (ROWNORM) { float f[8]; unpack8(ra[i], f);
#pragma unroll
        for (int e = 0; e < 8; ++e) ssq[i] += f[e] * f[e]; }
    }
#pragma unroll
    for (int i = 0; i < 2; ++i) *(u32x4*)(bs + (lrow + 64 * i) * GA_ST + lkc) = rb[i];
  };
  gload(0); lstore(0);
  __syncthreads();
  for (int kt = 0; kt < nk; ++kt) {
    const int buf = kt & 1;
    if (kt + 1 < nk) gload(kt + 1);
    const u16* as = As + buf * 256 * GA_ST + (wm * 64 + r) * GA_ST + h * 8;
    const u16* bs = Bs + buf * 128 * GA_ST + (wn * 64 + r) * GA_ST + h * 8;
#pragma unroll
    for (int ks = 0; ks < 4; ++ks) {
      const bf16x8 a0 = ld_frag16(as + ks * 16), a1 = ld_frag16(as + 32 * GA_ST + ks * 16);
      const bf16x8 b0 = ld_frag16(bs + ks * 16), b1 = ld_frag16(bs + 32 * GA_ST + ks * 16);
      acc[0][0] = MFMA32(b0, a0, acc[0][0]); acc[0][1] = MFMA32(b1, a0, acc[0][1]);
      acc[1][0] = MFMA32(b0, a1, acc[1][0]); acc[1][1] = MFMA32(b1, a1, acc[1][1]);
    }
    if constexpr (GROUPS) {
      if ((kt & 7) == 7) {
        const int g = kt >> 3;
        const float* ss = (const float*)(p.ws + OFF_SS);
#pragma unroll
        for (int mi = 0; mi < 2; ++mi) {
          const int row = m0 + wm * 64 + mi * 32 + r;
          const float sg = rsqrtf(ss[(size_t)row * 4 + g] * (1.0f / 512.0f) + 1e-6f);
          float sc = sg;
          if (g < 3) sc = sg * sqrtf(ss[(size_t)row * 4 + g + 1] * (1.0f / 512.0f) + 1e-6f);
#pragma unroll
          for (int ni = 0; ni < 2; ++ni)
#pragma unroll
            for (int e = 0; e < 16; ++e) acc[mi][ni][e] *= sc;
        }
      }
    }
    if (kt + 1 < nk) lstore(buf ^ 1);
    __syncthreads();
  }
  float rsv[2] = {1.f, 1.f};
  if constexpr (ROWNORM) {
#pragma unroll
    for (int i = 0; i < 4; ++i) {
      float s = ssq[i];
      s += __shfl_xor(s, 1); s += __shfl_xor(s, 2); s += __shfl_xor(s, 4);
      if ((tid & 7) == 0) ssrow[lrow + 64 * i] = s;
    }
    __syncthreads();
#pragma unroll
    for (int mi = 0; mi < 2; ++mi) rsv[mi] = rsqrtf(ssrow[wm * 64 + mi * 32 + r] / (float)K + 1e-6f);
  }
#pragma unroll
  for (int mi = 0; mi < 2; ++mi)
#pragma unroll
    for (int ni = 0; ni < 2; ++ni) {
      const int row = m0 + wm * 64 + mi * 32 + r, colbase = n0 + wn * 64 + ni * 32;
      gemm_epi<MODE>(p, row, colbase, h, acc[mi][ni], rsv[mi]);
    }
  __syncthreads();
}

template <int MODE>
DI void gemm_phase(const Params& p, const u16* A, int lda, const u16* Bt, int K, int Npad, int& rot, char* smem) {
  const int nN = Npad / 128, n = (T / 256) * nN, nb = gridDim.x;
  for (int it = (blockIdx.x + nb - rot) % nb; it < n; it += nb) gemm_tile<MODE>(p, A, lda, Bt, K, (it / nN) * 256, (it % nN) * 128, smem);
  rot = (rot + n) % nb;
}

DI float neg_expm1(float x) {
  if (x > -0.1f) return -x * (1.0f + x * (0.5f + x * ((1.0f / 6.0f) + x * ((1.0f / 24.0f) + x * (1.0f / 120.0f)))));
  return 1.0f - fast_exp(x);
}
DI void rglru_item(const Params& p, int item, char* smem) {
  char* ws = p.ws;
  const int hd = item & 7, bc = item >> 3, c = bc & 31, b = bc >> 5;
  const int t0 = b * SEQ + c * 128, s0 = c * 128;
  u16* Xc = (u16*)smem;
  u16* Was = (u16*)(smem + 18432);
  u16* Wxs = (u16*)(smem + 18432 + 9216);
  float* Xf = (float*)(smem + 36864);
  float* tend = (float*)(smem + 36864 + 33280);
  const int tid = threadIdx.x, lane = tid & 63, w = tid >> 6, r = lane & 31, h = lane >> 5;
  const u16* proj0 = (const u16*)(ws + OFF_PROJ0);
  {
    const int cc = (tid & 7) * 8, ch = hd * 64 + cc;
    float cw[4][8], cb[8];
#pragma unroll
    for (int k = 0; k < 4; ++k)
#pragma unroll
      for (int e = 0; e < 8; ++e) cw[k][e] = p.ab_conv_w[k * 512 + ch + e];
#pragma unroll
    for (int e = 0; e < 8; ++e) cb[e] = p.ab_conv_b[ch + e];
#pragma unroll
    for (int i = 0; i < 2; ++i) {
      const int l = (tid >> 3) + 64 * i;
      float xc[8];
#pragma unroll
      for (int e = 0; e < 8; ++e) xc[e] = cb[e];
#pragma unroll
      for (int k = 0; k < 4; ++k) {
        const int s = s0 + l - 3 + k;
        if (s >= 0) {
          const u32x4 v = *(const u32x4*)(proj0 + (size_t)(t0 + l - 3 + k) * LD0 + ch);
          float f[8]; unpack8(v, f);
#pragma unroll
          for (int e = 0; e < 8; ++e) xc[e] += cw[k][e] * f[e];
        }
      }
      *(u32x4*)(Xc + l * GA_ST + cc) = pack8(xc);
#pragma unroll
      for (int e = 0; e < 8; ++e) Xf[l * 65 + cc + e] = xc[e];
    }
    const int j = tid >> 3;
    *(u32x4*)(Was + j * GA_ST + cc) = *(const u32x4*)((const u16*)(ws + OFF_WAT) + hd * 4096 + j * 64 + cc);
    *(u32x4*)(Wxs + j * GA_ST + cc) = *(const u32x4*)((const u16*)(ws + OFF_WXT) + hd * 4096 + j * 64 + cc);
  }
  __syncthreads();
  const int lt = w & 3, jt = w >> 2;
  f32x16 accA, accX;
#pragma unroll
  for (int e = 0; e < 16; ++e) { accA[e] = 0.f; accX[e] = 0.f; }
#pragma unroll
  for (int ks = 0; ks < 4; ++ks) {
    const bf16x8 af = ld_frag16(Xc + (lt * 32 + r) * GA_ST + ks * 16 + h * 8);
    const bf16x8 ba = ld_frag16(Was + (jt * 32 + r) * GA_ST + ks * 16 + h * 8);
    const bf16x8 bx = ld_frag16(Wxs + (jt * 32 + r) * GA_ST + ks * 16 + h * 8);
    accA = MFMA32(ba, af, accA); accX = MFMA32(bx, af, accX);
  }
  float Av[16], Bv[16];
#pragma unroll
  for (int i = 0; i < 16; ++i) {
    const int j = jt * 32 + crow(i, h), chg = hd * 64 + j;
    const float ra_ = sigmoidf_(accA[i] + p.ga_b[chg]);
    const float ix = sigmoidf_(accX[i] + p.gx_b[chg]);
    const float sp = log1pf(expf(-p.lam[chg]));
    const float log_a = -8.0f * ra_ * sp;
    Av[i] = fast_exp(log_a);
    const float mult = sqrtf(neg_expm1(2.0f * log_a));
    Bv[i] = mult * ix * Xf[(lt * 32 + r) * 65 + j];
  }
#pragma unroll
  for (int d = 1; d < 32; d <<= 1) {
#pragma unroll
    for (int i = 0; i < 16; ++i) {
      const float Ap = __shfl_up(Av[i], d, 32), Bp = __shfl_up(Bv[i], d, 32);
      if (r >= d) { Bv[i] = Av[i] * Bp + Bv[i]; Av[i] = Av[i] * Ap; }
    }
  }
  if (r == 31) {
#pragma unroll
    for (int i = 0; i < 16; ++i) { const int j = jt * 32 + crow(i, h); tend[(lt * 64 + j) * 2] = Av[i]; tend[(lt * 64 + j) * 2 + 1] = Bv[i]; }
  }
  __syncthreads();
  const int t = t0 + lt * 32 + r;
  u16* hl = (u16*)(ws + OFF_HLOC) + (size_t)t * 512 + hd * 64;
  u16* pc = (u16*)(ws + OFF_PCUM) + (size_t)t * 512 + hd * 64;
  float hf[16], pf[16];
#pragma unroll
  for (int i = 0; i < 16; ++i) {
    const int j = jt * 32 + crow(i, h);
    float Hc = 0.f, Pp = 1.f;
    for (int tp = 0; tp < lt; ++tp) { const float Pe = tend[(tp * 64 + j) * 2], He = tend[(tp * 64 + j) * 2 + 1]; Hc = Pe * Hc + He; Pp *= Pe; }
    hf[i] = Bv[i] + Av[i] * Hc; pf[i] = Av[i] * Pp;
  }
#pragma unroll
  for (int g = 0; g < 4; ++g) {
    const int j = jt * 32 + 8 * g + 4 * h;
    u32x2 o; o.x = pk2(hf[4 * g], hf[4 * g + 1]); o.y = pk2(hf[4 * g + 2], hf[4 * g + 3]);
    *(u32x2*)(hl + j) = o;
    o.x = pk2(pf[4 * g], pf[4 * g + 1]); o.y = pk2(pf[4 * g + 2], pf[4 * g + 3]);
    *(u32x2*)(pc + j) = o;
  }
  if (lt == 3 && r == 31) {
    float* he = (float*)(ws + OFF_HEND) + (size_t)(b * 32 + c) * 512 + hd * 64;
    float* pe = (float*)(ws + OFF_PEND) + (size_t)(b * 32 + c) * 512 + hd * 64;
#pragma unroll
    for (int i = 0; i < 16; ++i) { const int j = jt * 32 + crow(i, h); he[j] = hf[i]; pe[j] = pf[i]; }
  }
  __syncthreads();
}

DI void krope_item(const Params& p, int item) {
  char* ws = p.ws;
  const u16* proj0 = (const u16*)(ws + OFF_PROJ0);
  const float* ct = (const float*)(ws + OFF_COS); const float* st = (const float*)(ws + OFF_SIN);
  u16* kc = (u16*)(ws + OFF_KC);
#pragma unroll
  for (int i = 0; i < 8; ++i) {
    const int u = threadIdx.x + NT * i, tl = u >> 4, j = u & 15, t = item * 256 + tl;
    const float x1 = bf2f(proj0[(size_t)t * LD0 + 1920 + j]), x2 = bf2f(proj0[(size_t)t * LD0 + 1936 + j]);
    const float c = ct[(size_t)t * 16 + j], s = st[(size_t)t * 16 + j];
    const u16 o1 = f2bf(x1 * c - x2 * s), o2 = f2bf(x2 * c + x1 * s);
#pragma unroll
    for (int hh = 0; hh < 8; ++hh) { kc[(size_t)t * 768 + hh * 96 + 64 + j] = o1; kc[(size_t)t * 768 + hh * 96 + 80 + j] = o2; }
  }
}

constexpr int KS_ST = 104, VS_ST = 72;
DI void attn_item(const Params& p, int bh, int qb, char* smem) {
  char* ws = p.ws;
  const int b = bh >> 3, hh = bh & 7;
  u16* Ks = (u16*)smem;
  u16* Vs = (u16*)(smem + 2 * 64 * KS_ST * 2);
  const int tid = threadIdx.x, lane = tid & 63, w = tid >> 6, r = lane & 31, h = lane >> 5;
  const int q0 = qb * 256, qw = q0 + w * 32, sq = qw + r;
  const size_t t = (size_t)b * SEQ + sq;
  const u16* Q = (const u16*)(ws + OFF_Q);
  const u16* Kc = (const u16*)(ws + OFF_KC) + (size_t)b * SEQ * 768 + hh * 96;
  const u16* Vt = (const u16*)(ws + OFF_VT) + (size_t)bh * 64 * SEQ;
  bf16x8 qf[6];
#pragma unroll
  for (int s = 0; s < 6; ++s) qf[s] = ld_frag16(Q + t * 768 + hh * 96 + s * 16 + h * 8);
  f32x16 o0, o1;
#pragma unroll
  for (int e = 0; e < 16; ++e) { o0[e] = 0.f; o1[e] = 0.f; }
  float m = -1e30f, l = 0.f;
  const int nkt = 4 * (qb + 1);
  const int c0 = tid, c1 = tid + NT;
  const int kr0 = c0 / 12, kc0 = (c0 % 12) * 8, kr1 = c1 / 12, kc1 = (c1 % 12) * 8;
  const bool has1 = c1 < 768;
  const int vd = tid >> 3, vk = (tid & 7) * 8;
  u32x4 rk0, rk1, rv;
  auto gload = [&](int kt) {
    const int k0 = kt * 64;
    rk0 = *(const u32x4*)(Kc + (size_t)(k0 + kr0) * 768 + kc0);
    if (has1) rk1 = *(const u32x4*)(Kc + (size_t)(k0 + kr1) * 768 + kc1);
    rv = *(const u32x4*)(Vt + (size_t)vd * SEQ + k0 + vk);
  };
  auto lstore = [&](int buf) {
    u16* ks = Ks + buf * 64 * KS_ST; u16* vs = Vs + buf * 64 * VS_ST;
    *(u32x4*)(ks + kr0 * KS_ST + kc0) = rk0;
    if (has1) *(u32x4*)(ks + kr1 * KS_ST + kc1) = rk1;
    *(u32x4*)(vs + vd * VS_ST + vk) = rv;
  };
  gload(0); lstore(0);
  __syncthreads();
  for (int kt = 0; kt < nkt; ++kt) {
    const int buf = kt & 1, k0 = kt * 64;
    if (kt + 1 < nkt) gload(kt + 1);
    if (k0 <= qw + 31) {
      const u16* ks = Ks + buf * 64 * KS_ST; const u16* vs = Vs + buf * 64 * VS_ST;
      f32x16 st0, st1;
#pragma unroll
      for (int e = 0; e < 16; ++e) { st0[e] = 0.f; st1[e] = 0.f; }
#pragma unroll
      for (int s = 0; s < 6; ++s) {
        const bf16x8 k0f = ld_frag16(ks + r * KS_ST + s * 16 + h * 8);
        const bf16x8 k1f = ld_frag16(ks + (32 + r) * KS_ST + s * 16 + h * 8);
        st0 = MFMA32(k0f, qf[s], st0); st1 = MFMA32(k1f, qf[s], st1);
      }
      if (k0 + 63 > qw) {
#pragma unroll
        for (int i = 0; i < 16; ++i) {
          const int key = k0 + crow(i, h);
          if (key > sq) st0[i] = -1e30f;
          if (key + 32 > sq) st1[i] = -1e30f;
        }
      }
      float mx = st0[0];
#pragma unroll
      for (int i = 1; i < 16; ++i) mx = fmaxf(mx, st0[i]);
#pragma unroll
      for (int i = 0; i < 16; ++i) mx = fmaxf(mx, st1[i]);
      mx = fmaxf(mx, __shfl_xor(mx, 32));
      const float mn = fmaxf(m, mx), alpha = fast_exp2(m - mn);
      float ls = 0.f;
#pragma unroll
      for (int i = 0; i < 16; ++i) { st0[i] = fast_exp2(st0[i] - mn); st1[i] = fast_exp2(st1[i] - mn); ls += st0[i] + st1[i]; }
      l = l * alpha + ls; m = mn;
#pragma unroll
      for (int e = 0; e < 16; ++e) { o0[e] *= alpha; o1[e] *= alpha; }
#pragma unroll
      for (int s = 0; s < 2; ++s) {
        const bf16x8 p0 = pack_frag(st0, s), p1 = pack_frag(st1, s);
        {
          const u16* v0 = vs + r * VS_ST + 16 * s + 4 * h;
          const bf16x8 va = ld_frag8x2(v0, v0 + 8), vb = ld_frag8x2(v0 + 32 * VS_ST, v0 + 32 * VS_ST + 8);
          o0 = MFMA32(va, p0, o0); o1 = MFMA32(vb, p0, o1);
        }
        {
          const u16* v1 = vs + r * VS_ST + 32 + 16 * s + 4 * h;
          const bf16x8 va = ld_frag8x2(v1, v1 + 8), vb = ld_frag8x2(v1 + 32 * VS_ST, v1 + 32 * VS_ST + 8);
          o0 = MFMA32(va, p1, o0); o1 = MFMA32(vb, p1, o1);
        }
      }
    }
    if (kt + 1 < nkt) lstore(buf ^ 1);
    __syncthreads();
  }
  const float lt = l + __shfl_xor(l, 32), inv = 1.0f / lt;
  const u16* sg = (const u16*)(ws + OFF_PROJ0) + t * LD0 + 1024 + hh * 64;
  u16* yc = (u16*)(ws + OFF_YCAT) + t * 1024 + 512 + hh * 64;
#pragma unroll
  for (int dt = 0; dt < 2; ++dt)
#pragma unroll
    for (int g = 0; g < 4; ++g) {
      const int d = dt * 32 + 8 * g + 4 * h;
      const u32x2 gv = *(const u32x2*)(sg + d);
      const f32x16& o = dt ? o1 : o0;
      u32x2 ov;
      ov.x = pk2(o[4 * g] * inv * bflo(gv.x), o[4 * g + 1] * inv * bfhi(gv.x));
      ov.y = pk2(o[4 * g + 2] * inv * bflo(gv.y), o[4 * g + 3] * inv * bfhi(gv.y));
      *(u32x2*)(yc + d) = ov;
    }
}

DI void fixup_item(const Params& p, int item, char* smem) {
  char* ws = p.ws;
  const int b = item >> 5, c = item & 31, tid = threadIdx.x;
  float* Hin = (float*)smem;
  {
    const float* he = (const float*)(ws + OFF_HEND) + (size_t)(b * 32) * 512 + tid;
    const float* pe = (const float*)(ws + OFF_PEND) + (size_t)(b * 32) * 512 + tid;
    float H = 0.f;
    for (int cp = 0; cp < c; ++cp) H = pe[cp * 512] * H + he[cp * 512];
    Hin[tid] = H;
  }
  __syncthreads();
  const size_t t0 = (size_t)b * SEQ + c * 128;
  const u16* hl = (const u16*)(ws + OFF_HLOC); const u16* pc = (const u16*)(ws + OFF_PCUM);
  const u16* proj0 = (const u16*)(ws + OFF_PROJ0); u16* yc = (u16*)(ws + OFF_YCAT);
#pragma unroll 4
  for (int i = 0; i < 16; ++i) {
    const int u = tid + NT * i, l = u >> 6, cc = (u & 63) * 8;
    const size_t tt = t0 + l;
    const u32x4 hv = *(const u32x4*)(hl + tt * 512 + cc), pv = *(const u32x4*)(pc + tt * 512 + cc), gv = *(const u32x4*)(proj0 + tt * LD0 + 512 + cc);
    float hf[8], pf[8], gf[8], o[8];
    unpack8(hv, hf); unpack8(pv, pf); unpack8(gv, gf);
#pragma unroll
    for (int e = 0; e < 8; ++e) o[e] = (hf[e] + pf[e] * Hin[cc + e]) * gf[e];
    *(u32x4*)(yc + tt * 1024 + cc) = pack8(o);
  }
  __syncthreads();
}

DI void ln_phase(const Params& p, const float* __restrict__ g, const float* __restrict__ bta, u16* xb) {
  const int lane = threadIdx.x & 63, gw = blockIdx.x * 8 + (threadIdx.x >> 6), nw = gridDim.x * 8;
  f32x4 gg[4], bb[4];
#pragma unroll
  for (int i = 0; i < 4; ++i) { gg[i] = *(const f32x4*)(g + i * 256 + lane * 4); bb[i] = *(const f32x4*)(bta + i * 256 + lane * 4); }
  for (int row = gw; row < T; row += nw) {
    float* pr = p.out + (size_t)row * 1024;
    f32x4 v[4];
    float s = 0.f;
#pragma unroll
    for (int i = 0; i < 4; ++i) { v[i] = *(const f32x4*)(pr + i * 256 + lane * 4); s += (v[i].x + v[i].y) + (v[i].z + v[i].w); }
#pragma unroll
    for (int d = 1; d < 64; d <<= 1) s += __shfl_xor(s, d);
    const float mu = s * (1.0f / 1024.0f);
    float q = 0.f;
#pragma unroll
    for (int i = 0; i < 4; ++i) { v[i].x -= mu; v[i].y -= mu; v[i].z -= mu; v[i].w -= mu; q += (v[i].x * v[i].x + v[i].y * v[i].y) + (v[i].z * v[i].z + v[i].w * v[i].w); }
#pragma unroll
    for (int d = 1; d < 64; d <<= 1) q += __shfl_xor(q, d);
    const float rstd = rsqrtf(q * (1.0f / 1024.0f) + 1e-5f);
#pragma unroll
    for (int i = 0; i < 4; ++i) {
      f32x4 o;
      o.x = v[i].x * rstd * gg[i].x + bb[i].x; o.y = v[i].y * rstd * gg[i].y + bb[i].y; o.z = v[i].z * rstd * gg[i].z + bb[i].z; o.w = v[i].w * rstd * gg[i].w + bb[i].w;
      *(f32x4*)(pr + i * 256 + lane * 4) = o;
      if (xb) { u32x2 w; w.x = pk2(o.x, o.y); w.y = pk2(o.z, o.w); *(u32x2*)(xb + (size_t)row * 1024 + i * 256 + lane * 4) = w; }
    }
  }
}

DI void bcconv_phase(const Params& p) {
  char* ws = p.ws;
  const u16* proj1 = (const u16*)(ws + OFF_PROJ1); u16* bc = (u16*)(ws + OFF_BC);
  const size_t gid = (size_t)blockIdx.x * NT + threadIdx.x, gstride = (size_t)gridDim.x * NT;
  const int j8 = (int)(gid & 127) * 8;
  float cw[4][8], cb[8];
#pragma unroll
  for (int k = 0; k < 4; ++k)
#pragma unroll
    for (int e = 0; e < 8; ++e) cw[k][e] = p.ssd_conv_w[k * 3072 + 2048 + j8 + e];
#pragma unroll
  for (int e = 0; e < 8; ++e) cb[e] = p.ssd_conv_b[2048 + j8 + e];
  for (size_t u = gid; u < (size_t)T * 128; u += gstride) {
    const size_t t = u >> 7; const int s = (int)(t & 4095);
    float a[8];
#pragma unroll
    for (int e = 0; e < 8; ++e) a[e] = cb[e];
#pragma unroll
    for (int k = 0; k < 4; ++k) {
      if (s - 3 + k >= 0) {
        const u32x4 v = *(const u32x4*)(proj1 + (t - 3 + k) * LD1 + 4096 + j8);
        float f[8]; unpack8(v, f);
#pragma unroll
        for (int e = 0; e < 8; ++e) a[e] += cw[k][e] * f[e];
      }
    }
#pragma unroll
    for (int e = 0; e < 8; ++e) a[e] = siluf_(a[e]);
    *(u32x4*)(bc + t * 1024 + j8) = pack8(a);
  }
}

constexpr int SS_ST = 136;
DI void ssd_item(const Params& p, int item, char* smem) {
  char* ws = p.ws;
  const int b = item >> 5, hd = item & 31, g = hd >> 3;
  u16* Cs = (u16*)smem;
  u16* Bs = (u16*)(smem + 34816);
  u16* Bd = (u16*)(smem + 2 * 34816);
  u16* Xt = (u16*)(smem + 3 * 34816);
  u16* St = (u16*)(smem + 3 * 34816 + 17408);
  u16* Xs = (u16*)(smem + 3 * 34816 + 2 * 17408);
  float* cs = (float*)(smem + 3 * 34816 + 2 * 17408 + 18432);
  float* dts = cs + 128;
  const int tid = threadIdx.x, lane = tid & 63, w = tid >> 6, r = lane & 31, h = lane >> 5;
  const float a_neg = -expf(p.a_log[hd]), Dh = p.ssd_d[hd];
  u16* proj1 = (u16*)(ws + OFF_PROJ1);
  const u16* bcg = (const u16*)(ws + OFF_BC);
  const float* dtb = (const float*)(ws + OFF_DT);
  float* ssb = (float*)(ws + OFF_SS);
  const int xcc = (tid & 7) * 8, xch = hd * 64 + xcc;
  float cw[4][8], cb[8];
#pragma unroll
  for (int k = 0; k < 4; ++k)
#pragma unroll
    for (int e = 0; e < 8; ++e) cw[k][e] = p.ssd_conv_w[k * 3072 + xch + e];
#pragma unroll
  for (int e = 0; e < 8; ++e) cb[e] = p.ssd_conv_b[xch + e];
  f32x16 stacc;
#pragma unroll
  for (int e = 0; e < 16; ++e) stacc[e] = 0.f;
  for (int i = tid; i < 64 * SS_ST / 2; i += NT) ((unsigned*)St)[i] = 0u;
  const int lt = (w < 4) ? w : 7 - w, pt = w >> 2, nt = w & 3;
  for (int c = 0; c < 32; ++c) {
    const size_t t0 = (size_t)b * SEQ + c * 128;
    if (w == 0) {
      const float d0 = dtb[(t0 + 2 * lane) * 32 + hd], d1 = dtb[(t0 + 2 * lane + 1) * 32 + hd];
      const float a0 = d0 * a_neg, a1 = d1 * a_neg;
      float s = a0 + a1;
#pragma unroll
      for (int d = 1; d < 64; d <<= 1) { const float o = __shfl_up(s, d, 64); if (lane >= d) s += o; }
      cs[2 * lane] = s - a1; cs[2 * lane + 1] = s;
      dts[2 * lane] = d0; dts[2 * lane + 1] = d1;
    }
    __syncthreads();
    const float csT = cs[127];
#pragma unroll
    for (int i = 0; i < 2; ++i) {
      const int l = (tid >> 3) + 64 * i;
      float xv[8];
#pragma unroll
      for (int e = 0; e < 8; ++e) xv[e] = cb[e];
#pragma unroll
      for (int k = 0; k < 4; ++k) {
        if (c * 128 + l - 3 + k >= 0) {
          const u32x4 v = *(const u32x4*)(proj1 + (t0 + l - 3 + k) * LD1 + 2048 + xch);
          float f[8]; unpack8(v, f);
#pragma unroll
          for (int e = 0; e < 8; ++e) xv[e] += cw[k][e] * f[e];
        }
      }
#pragma unroll
      for (int e = 0; e < 8; ++e) xv[e] = siluf_(xv[e]);
      *(u32x4*)(Xs + l * GA_ST + xcc) = pack8(xv);
      const float dl = dts[l];
#pragma unroll
      for (int e = 0; e < 8; ++e) Xt[(xcc + e) * SS_ST + l] = f2bf(xv[e] * dl);
    }
#pragma unroll
    for (int i = 0; i < 4; ++i) {
      const int u = tid + NT * i, l = u >> 4, cc = (u & 15) * 8;
      const u32x4 bv = *(const u32x4*)(bcg + (t0 + l) * 1024 + g * 128 + cc);
      const u32x4 cv = *(const u32x4*)(bcg + (t0 + l) * 1024 + 512 + g * 128 + cc);
      *(u32x4*)(Bs + l * SS_ST + cc) = bv;
      *(u32x4*)(Cs + l * SS_ST + cc) = cv;
      const float dec = fast_exp(csT - cs[l]);
      float f[8]; unpack8(bv, f);
#pragma unroll
      for (int e = 0; e < 8; ++e) Bd[(cc + e) * SS_ST + l] = f2bf(f[e] * dec);
    }
    __syncthreads();
    {
      const int l = lt * 32 + r;
      const float csl = cs[l];
      f32x16 yd, yo;
#pragma unroll
      for (int e = 0; e < 16; ++e) { yd[e] = 0.f; yo[e] = 0.f; }
      for (int st = 0; st <= lt; ++st) {
        f32x16 cb_;
#pragma unroll
        for (int e = 0; e < 16; ++e) cb_[e] = 0.f;
#pragma unroll
        for (int ks = 0; ks < 8; ++ks) {
          const bf16x8 bf = ld_frag16(Bs + (st * 32 + r) * SS_ST + ks * 16 + h * 8);
          const bf16x8 cf = ld_frag16(Cs + l * SS_ST + ks * 16 + h * 8);
          cb_ = MFMA32(bf, cf, cb_);
        }
#pragma unroll
        for (int i = 0; i < 16; ++i) {
          const int s = st * 32 + crow(i, h);
          const float dec = fast_exp(csl - cs[s]);
          cb_[i] = (s <= l) ? cb_[i] * dec : 0.f;
        }
#pragma unroll
        for (int s2 = 0; s2 < 2; ++s2) {
          const bf16x8 pf = pack_frag(cb_, s2);
          const u16* x0 = Xt + (pt * 32 + r) * SS_ST + st * 32 + 16 * s2 + 4 * h;
          const bf16x8 xf = ld_frag8x2(x0, x0 + 8);
          yd = MFMA32(xf, pf, yd);
        }
      }
#pragma unroll
      for (int ks = 0; ks < 8; ++ks) {
        const bf16x8 sf = ld_frag16(St + (pt * 32 + r) * SS_ST + ks * 16 + h * 8);
        const bf16x8 cf = ld_frag16(Cs + l * SS_ST + ks * 16 + h * 8);
        yo = MFMA32(sf, cf, yo);
      }
      const float el = fast_exp(csl);
      const size_t t = t0 + l;
      u16* zrow = proj1 + t * LD1 + hd * 64;
      float ssq = 0.f;
#pragma unroll
      for (int gq = 0; gq < 4; ++gq) {
        const int pb = pt * 32 + 8 * gq + 4 * h;
        const u32x2 xv = *(const u32x2*)(Xs + l * GA_ST + pb);
        const u32x2 zv = *(const u32x2*)(zrow + pb);
        const float y0 = (yd[4 * gq] + el * yo[4 * gq] + Dh * bflo(xv.x)) * bflo(zv.x);
        const float y1 = (yd[4 * gq + 1] + el * yo[4 * gq + 1] + Dh * bfhi(xv.x)) * bfhi(zv.x);
        const float y2 = (yd[4 * gq + 2] + el * yo[4 * gq + 2] + Dh * bflo(xv.y)) * bflo(zv.y);
        const float y3 = (yd[4 * gq + 3] + el * yo[4 * gq + 3] + Dh * bfhi(xv.y)) * bfhi(zv.y);
        ssq += (y0 * y0 + y1 * y1) + (y2 * y2 + y3 * y3);
        u32x2 ov; ov.x = pk2(y0, y1); ov.y = pk2(y2, y3);
        *(u32x2*)(zrow + pb) = ov;
      }
      ssq += __shfl_xor(ssq, 32);
      if (h == 0) atomicAdd(ssb + t * 4 + g, ssq);
    }
    {
      const float dT = fast_exp(csT);
#pragma unroll
      for (int e = 0; e < 16; ++e) stacc[e] *= dT;
#pragma unroll
      for (int ks = 0; ks < 8; ++ks) {
        const bf16x8 bf = ld_frag16(Bd + (nt * 32 + r) * SS_ST + ks * 16 + h * 8);
        const bf16x8 xf = ld_frag16(Xt + (pt * 32 + r) * SS_ST + ks * 16 + h * 8);
        stacc = MFMA32(bf, xf, stacc);
      }
    }
    __syncthreads();
#pragma unroll
    for (int gq = 0; gq < 4; ++gq) {
      u32x2 ov; ov.x = pk2(stacc[4 * gq], stacc[4 * gq + 1]); ov.y = pk2(stacc[4 * gq + 2], stacc[4 * gq + 3]);
      *(u32x2*)(St + (pt * 32 + r) * SS_ST + nt * 32 + 8 * gq + 4 * h) = ov;
    }
  }
  __syncthreads();
}

__global__ void __launch_bounds__(NT) fwd_megakernel(Params p) {
  __shared__ __attribute__((aligned(16))) char smem[160 * 1024];
  cg::grid_group grid = cg::this_grid();
  char* ws = p.ws;
  const int nb = gridDim.x, bid = blockIdx.x;
  int rot = 0;
  phase_prep(p, smem);
  grid.sync();
  gemm_phase<1>(p, (const u16*)(ws + OFF_XB), 1024, (const u16*)(ws + OFF_W1T), 1024, 2048, rot, smem);
  grid.sync();
  for (int it = (bid + nb - rot) % nb; it < 2048; it += nb) rglru_item(p, it, smem);
  rot = (rot + 2048) % nb;
  gemm_phase<2>(p, (const u16*)(ws + OFF_PROJ0) + 1536, LD0, (const u16*)(ws + OFF_WQT), 256, 768, rot, smem);
  gemm_phase<3>(p, (const u16*)(ws + OFF_PROJ0) + 1792, LD0, (const u16*)(ws + OFF_WKVT), 128, 1024, rot, smem);
  for (int it = (bid + nb - rot) % nb; it < 128; it += nb) krope_item(p, it);
  rot = (rot + 128) % nb;
  grid.sync();
  for (int it = bid; it < 1024; it += nb) {
    const int j = it & 255, i = it >> 8, g = j >> 6, bh = j & 63;
    const int qb = (i == 0) ? 15 - g : (i == 1) ? 8 + g : (i == 2) ? 7 - g : g;
    attn_item(p, bh, qb, smem);
  }
  for (int it = bid; it < 256; it += nb) fixup_item(p, it, smem);
  grid.sync();
  rot = 0;
  gemm_phase<4>(p, (const u16*)(ws + OFF_YCAT), 1024, (const u16*)(ws + OFF_WOT), 1024, 1024, rot, smem);
  grid.sync();
  ln_phase(p, p.ab_ln_g, p.ab_ln_b, (u16*)(ws + OFF_X1B));
  grid.sync();
  rot = 0;
  gemm_phase<5>(p, (const u16*)(ws + OFF_X1B), 1024, (const u16*)(ws + OFF_W2T), 1024, 5248, rot, smem);
  grid.sync();
  bcconv_phase(p);
  grid.sync();
  for (int it = bid; it < 256; it += nb) ssd_item(p, it, smem);
  grid.sync();
  rot = 0;
  gemm_phase<6>(p, (const u16*)(ws + OFF_PROJ1), LD1, (const u16*)(ws + OFF_W3T), 2048, 1024, rot, smem);
  grid.sync();
  ln_phase(p, p.ssd_ln_g, p.ssd_ln_b, nullptr);
}

extern "C" void kernel_launch(void* const* d_in, const int* in_sizes, int n_in, void* d_out, int out_size, void* d_ws, size_t ws_size, hipStream_t stream) {
  static int grid_blocks = 0;
  if (!grid_blocks) {
    int dev = 0, cus = 0, per_cu = 0;
    hipGetDevice(&dev);
    hipDeviceGetAttribute(&cus, hipDeviceAttributeMultiprocessorCount, dev);
    hipOccupancyMaxActiveBlocksPerMultiprocessor(&per_cu, fwd_megakernel, NT, 0);
    if (per_cu < 1) per_cu = 1;
    grid_blocks = cus * per_cu;
  }
  Params p{};
  p.x = (const float*)d_in[0]; p.pos = (const int*)d_in[1];
  p.ab_w_in = (const float*)d_in[2]; p.ab_conv_w = (const float*)d_in[3]; p.ab_conv_b = (const float*)d_in[4];
  p.ga_w = (const float*)d_in[5]; p.ga_b = (const float*)d_in[6]; p.gx_w = (const float*)d_in[7]; p.gx_b = (const float*)d_in[8];
  p.lam = (const float*)d_in[9]; p.qn = (const float*)d_in[10]; p.kvn = (const float*)d_in[11]; p.w_uq = (const float*)d_in[12];
  p.w_ukv = (const float*)d_in[13]; p.ab_w_out = (const float*)d_in[14]; p.ab_ln_g = (const float*)d_in[15]; p.ab_ln_b = (const float*)d_in[16];
  p.ssd_w_in = (const float*)d_in[17]; p.ssd_conv_w = (const float*)d_in[18]; p.ssd_conv_b = (const float*)d_in[19]; p.dt_bias = (const float*)d_in[20];
  p.a_log = (const float*)d_in[21]; p.ssd_d = (const float*)d_in[22]; p.ssd_norm = (const float*)d_in[23]; p.ssd_w_out = (const float*)d_in[24];
  p.ssd_ln_g = (const float*)d_in[25]; p.ssd_ln_b = (const float*)d_in[26];
  p.out = (float*)d_out; p.ws = (char*)d_ws;
  void* args[] = {&p};
  hipError_t e = hipLaunchCooperativeKernel((void*)fwd_megakernel, dim3(grid_blocks), dim3(NT), args, 0, stream);
  if (e != hipSuccess) fprintf(stderr, "cooperative launch failed: %s (grid %d)\n", hipGetErrorString(e), grid_blocks);
}
```

```cpp
#include <hip/hip_runtime.h>
#include <hip/hip_cooperative_groups.h>
#include <cstdio>
namespace cg = cooperative_groups;

typedef unsigned short u16;
typedef short bf16x8 __attribute__((ext_vector_type(8)));
typedef short s16x4 __attribute__((ext_vector_type(4)));
typedef float f32x16 __attribute__((ext_vector_type(16)));
typedef float f32x4 __attribute__((ext_vector_type(4)));
typedef unsigned u32x4 __attribute__((ext_vector_type(4)));
typedef unsigned u32x2 __attribute__((ext_vector_type(2)));
typedef __bf16 bf2_t __attribute__((ext_vector_type(2)));

#define DI __device__ __forceinline__
#define NT 512
__device__ __forceinline__ int tid_() { int t = threadIdx.x; asm volatile("" : "+v"(t)); return t; }
#define MFMA32(a, b, c) __builtin_amdgcn_mfma_f32_32x32x16_bf16((a), (b), (c), 0, 0, 0)

constexpr int T = 32768, SEQ = 4096;
constexpr float DN_ALPHA = 1.41421356237309515f;
constexpr size_t Mi = 1024ull * 1024ull;
constexpr size_t OFF_W1T = 0, OFF_WOT = 4 * Mi, OFF_W2T = 6 * Mi, OFF_W3T = 16 * Mi + 512 * 1024, OFF_WQT = 20 * Mi + 512 * 1024,
                 OFF_WKVT = 21 * Mi, OFF_WAT = 21 * Mi + 256 * 1024, OFF_WXT = 21 * Mi + 320 * 1024, OFF_COS = 21 * Mi + 512 * 1024,
                 OFF_SIN = 23 * Mi + 512 * 1024, OFF_HEND = 25 * Mi + 512 * 1024, OFF_PEND = 26 * Mi, OFF_SS = 26 * Mi + 512 * 1024,
                 OFF_DT = 27 * Mi, OFF_XB = 32 * Mi, OFF_YCAT = 32 * Mi, OFF_X1B = 32 * Mi, OFF_BC = 32 * Mi, OFF_PROJ0 = 96 * Mi,
                 OFF_HLOC = 224 * Mi, OFF_PCUM = 256 * Mi, OFF_Q = 288 * Mi, OFF_KC = 336 * Mi, OFF_VT = 384 * Mi, OFF_PROJ1 = 96 * Mi;
constexpr int LD0 = 2048, LD1 = 5376;

struct Params {
  const float* x; const int* pos;
  const float *ab_w_in, *ab_conv_w, *ab_conv_b, *ga_w, *ga_b, *gx_w, *gx_b, *lam, *qn, *kvn, *w_uq, *w_ukv, *ab_w_out, *ab_ln_g, *ab_ln_b;
  const float *ssd_w_in, *ssd_conv_w, *ssd_conv_b, *dt_bias, *a_log, *ssd_d, *ssd_norm, *ssd_w_out, *ssd_ln_g, *ssd_ln_b;
  float* out; char* ws;
};

DI unsigned pk2(float a, float b) { bf2_t v; v[0] = (__bf16)a; v[1] = (__bf16)b; return __builtin_bit_cast(unsigned, v); }
DI u16 f2bf(float a) { __bf16 v = (__bf16)a; return __builtin_bit_cast(u16, v); }
DI float bflo(unsigned w) { return __uint_as_float(w << 16); }
DI float bfhi(unsigned w) { return __uint_as_float(w & 0xffff0000u); }
DI float bf2f(u16 v) { return __uint_as_float(((unsigned)v) << 16); }
DI float fast_exp2(float x) { return __builtin_amdgcn_exp2f(x); }
DI float fast_exp(float x) { return __builtin_amdgcn_exp2f(x * 1.44269504088896341f); }
DI float fast_rcp(float x) { return __builtin_amdgcn_rcpf(x); }
DI float sigmoidf_(float x) { return fast_rcp(1.0f + fast_exp(-x)); }
DI float siluf_(float x) { return x * sigmoidf_(x); }
DI int crow(int i, int h) { return (i & 3) + 8 * (i >> 2) + 4 * h; }
DI void unpack8(const u32x4& v, float* f) {
  f[0] = bflo(v.x); f[1] = bfhi(v.x); f[2] = bflo(v.y); f[3] = bfhi(v.y); f[4] = bflo(v.z); f[5] = bfhi(v.z); f[6] = bflo(v.w); f[7] = bfhi(v.w);
}
DI u32x4 pack8(const float* f) { u32x4 v; v.x = pk2(f[0], f[1]); v.y = pk2(f[2], f[3]); v.z = pk2(f[4], f[5]); v.w = pk2(f[6], f[7]); return v; }
DI bf16x8 pack_frag(const f32x16& x, int s) {
  u32x4 v; v.x = pk2(x[8 * s], x[8 * s + 1]); v.y = pk2(x[8 * s + 2], x[8 * s + 3]); v.z = pk2(x[8 * s + 4], x[8 * s + 5]); v.w = pk2(x[8 * s + 6], x[8 * s + 7]);
  return __builtin_bit_cast(bf16x8, v);
}
DI bf16x8 ld_frag16(const u16* p) { return *(const bf16x8*)p; }
DI bf16x8 ld_frag8x2(const u16* p0, const u16* p1) {
  s16x4 lo = *(const s16x4*)p0, hi = *(const s16x4*)p1;
  return __builtin_shufflevector(lo, hi, 0, 1, 2, 3, 4, 5, 6, 7);
}

DI void tr_tile(const float* __restrict__ src, u16* __restrict__ dst, int K, int N, const float* __restrict__ scale, int kt, int nt, char* smem) {
  float* tf = (float*)smem;
  const int tid = tid_(), k0 = kt * 64, n0 = nt * 64;
#pragma unroll
  for (int i = 0; i < 8; ++i) {
    const int kk = (tid >> 6) + 8 * i, nn = tid & 63;
    float v = 0.f;
    if (n0 + nn < N) { v = src[(size_t)(k0 + kk) * N + n0 + nn]; if (scale) v *= scale[k0 + kk]; }
    tf[kk * 65 + nn] = v;
  }
  __syncthreads();
#pragma unroll
  for (int i = 0; i < 8; ++i) {
    const int nn = (tid >> 6) + 8 * i, kk = tid & 63;
    dst[(size_t)(n0 + nn) * K + k0 + kk] = f2bf(tf[kk * 65 + nn]);
  }
  __syncthreads();
}
DI void tr_job(const float* src, u16* dst, int K, int N, int Npad, const float* scale, int& rot, char* smem) {
  const int nkt = K / 64, nnt = Npad / 64, n = nkt * nnt, nb = gridDim.x;
  for (int it = (blockIdx.x + nb - rot) % nb; it < n; it += nb) tr_tile(src, dst, K, N, scale, it % nkt, it / nkt, smem);
  rot = (rot + n) % nb;
}

DI void phase_prep(const Params& p, char* smem) {
  char* ws = p.ws;
  int rot = 0;
  tr_job(p.ab_w_in, (u16*)(ws + OFF_W1T), 1024, 1952, 2048, nullptr, rot, smem);
  tr_job(p.ssd_w_in, (u16*)(ws + OFF_W2T), 1024, 5152, 5376, nullptr, rot, smem);
  tr_job(p.ab_w_out, (u16*)(ws + OFF_WOT), 1024, 1024, 1024, nullptr, rot, smem);
  tr_job(p.ssd_w_out, (u16*)(ws + OFF_W3T), 2048, 1024, 1024, p.ssd_norm, rot, smem);
  tr_job(p.w_uq, (u16*)(ws + OFF_WQT), 256, 768, 768, p.qn, rot, smem);
  tr_job(p.w_ukv, (u16*)(ws + OFF_WKVT), 128, 1024, 1024, p.kvn, rot, smem);
  for (int hd = 0; hd < 8; ++hd) {
    tr_job(p.ga_w + hd * 4096, (u16*)(ws + OFF_WAT) + hd * 4096, 64, 64, 64, nullptr, rot, smem);
    tr_job(p.gx_w + hd * 4096, (u16*)(ws + OFF_WXT) + hd * 4096, 64, 64, 64, nullptr, rot, smem);
  }
  const size_t gid = (size_t)blockIdx.x * NT + tid_(), gstride = (size_t)gridDim.x * NT;
  {
    const f32x4* xs = (const f32x4*)p.x; u32x4* xb = (u32x4*)(ws + OFF_XB);
    const size_t n8 = (size_t)T * 1024 / 8;
    for (size_t i = gid; i < n8; i += gstride) {
      const f32x4 a = xs[2 * i], b = xs[2 * i + 1];
      u32x4 o; o.x = pk2(a.x, a.y); o.y = pk2(a.z, a.w); o.z = pk2(b.x, b.y); o.w = pk2(b.z, b.w);
      xb[i] = o;
    }
  }
  {
    float* ct = (float*)(ws + OFF_COS); float* st = (float*)(ws + OFF_SIN);
    for (size_t i = gid; i < (size_t)T * 16; i += gstride) {
      const int t = (int)(i >> 4), j = (int)(i & 15);
      const float inv = exp2f(-(float)j * (13.287712379549449f / 16.0f));
      const float ang = (float)p.pos[t] * inv;
      const double rev = (double)ang * 0.15915494309189535;
      const double fr = rev - rint(rev);
      const float a = (float)(fr * 6.283185307179586);
      ct[i] = cosf(a); st[i] = sinf(a);
    }
  }
  {
    float* ss = (float*)(ws + OFF_SS);
    for (size_t i = gid; i < (size_t)T * 4; i += gstride) ss[i] = 0.f;
  }
}

constexpr int GA_ST = 72;
constexpr float QSCALE = 0.10206207261596575f * 1.44269504088896341f;

template <int MODE>
DI void gemm_epi(const Params& p, int row, int colbase, int h, const f32x16& v, float rs) {
  char* ws = p.ws;
  if constexpr (MODE == 1) {
    u16* dst = (u16*)(ws + OFF_PROJ0) + (size_t)row * LD0;
#pragma unroll
    for (int g = 0; g < 4; ++g) {
      const int col = colbase + 8 * g + 4 * h;
      float a = v[4 * g], b = v[4 * g + 1], c = v[4 * g + 2], d = v[4 * g + 3];
      if (col >= 512 && col < 1536) { a = siluf_(a); b = siluf_(b); c = siluf_(c); d = siluf_(d); }
      u32x2 o; o.x = pk2(a, b); o.y = pk2(c, d);
      *(u32x2*)(dst + col) = o;
    }
  } else if constexpr (MODE == 2) {
    u16* dst = (u16*)(ws + OFF_Q) + (size_t)row * 768;
    f32x16 o;
    if ((colbase % 96) == 64) {
      const float* ct = (const float*)(ws + OFF_COS) + (size_t)row * 16;
      const float* st = (const float*)(ws + OFF_SIN) + (size_t)row * 16;
#pragma unroll
      for (int i = 0; i < 8; ++i) {
        const int idx = crow(i, h);
        const float c = ct[idx], s = st[idx], x1 = v[i] * rs, x2 = v[i + 8] * rs;
        o[i] = (x1 * c - x2 * s) * QSCALE; o[i + 8] = (x2 * c + x1 * s) * QSCALE;
      }
    } else {
#pragma unroll
      for (int i = 0; i < 16; ++i) o[i] = v[i] * (rs * QSCALE);
    }
#pragma unroll
    for (int g = 0; g < 4; ++g) {
      u32x2 w; w.x = pk2(o[4 * g], o[4 * g + 1]); w.y = pk2(o[4 * g + 2], o[4 * g + 3]);
      *(u32x2*)(dst + colbase + 8 * g + 4 * h) = w;
    }
  } else if constexpr (MODE == 3) {
    const int hd = colbase >> 7, within = colbase & 127;
    if (within < 64) {
      u16* dst = (u16*)(ws + OFF_KC) + (size_t)row * 768 + hd * 96 + within;
#pragma unroll
      for (int g = 0; g < 4; ++g) {
        u32x2 w; w.x = pk2(v[4 * g] * rs, v[4 * g + 1] * rs); w.y = pk2(v[4 * g + 2] * rs, v[4 * g + 3] * rs);
        *(u32x2*)(dst + 8 * g + 4 * h) = w;
      }
    } else {
      const int b = row >> 12, s = row & 4095;
      u16* dst = (u16*)(ws + OFF_VT) + ((size_t)(b * 8 + hd) * 64 + (within - 64)) * SEQ + s;
#pragma unroll
      for (int i = 0; i < 16; ++i) dst[(size_t)crow(i, h) * SEQ] = f2bf(v[i] * rs);
    }
  } else if constexpr (MODE == 4 || MODE == 6) {
    const float* src = (MODE == 4) ? p.x : p.out;
#pragma unroll
    for (int g = 0; g < 4; ++g) {
      const size_t off = (size_t)row * 1024 + colbase + 8 * g + 4 * h;
      const f32x4 xv = *(const f32x4*)(src + off);
      f32x4 o; o.x = DN_ALPHA * xv.x + v[4 * g]; o.y = DN_ALPHA * xv.y + v[4 * g + 1]; o.z = DN_ALPHA * xv.z + v[4 * g + 2]; o.w = DN_ALPHA * xv.w + v[4 * g + 3];
      *(f32x4*)(p.out + off) = o;
    }
  } else if constexpr (MODE == 5) {
    if (colbase < 5120) {
      u16* dst = (u16*)(ws + OFF_PROJ1) + (size_t)row * LD1;
#pragma unroll
      for (int g = 0; g < 4; ++g) {
        const int col = colbase + 8 * g + 4 * h;
        float a = v[4 * g], b = v[4 * g + 1], c = v[4 * g + 2], d = v[4 * g + 3];
        if (col < 2048) { a = siluf_(a); b = siluf_(b); c = siluf_(c); d = siluf_(d); }
        u32x2 o; o.x = pk2(a, b); o.y = pk2(c, d);
        *(u32x2*)(dst + col) = o;
      }
    } else if (colbase == 5120) {
      float* dst = (float*)(ws + OFF_DT) + (size_t)row * 32;
#pragma unroll
      for (int i = 0; i < 16; ++i) {
        const int c = crow(i, h);
        const float xv = v[i] + p.dt_bias[c];
        dst[c] = fmaxf(xv, 0.f) + log1pf(expf(-fabsf(xv)));
      }
    }
  }
}

template <int MODE>
DI void gemm_tile(const Params& p, const u16* __restrict__ A, int lda, const u16* __restrict__ Bt, int K, int m0, int n0, char* smem) {
  constexpr bool ROWNORM = (MODE == 2 || MODE == 3);
  constexpr bool GROUPS = (MODE == 6);
  u16* As = (u16*)smem;
  u16* Bs = (u16*)(smem + 2 * 256 * GA_ST * 2);
  float* ssrow = (float*)(smem + 2 * 256 * GA_ST * 2 + 2 * 128 * GA_ST * 2);
  const int tid = tid_(), lane = tid & 63, w = tid >> 6, wm = w & 3, wn = w >> 2, r = lane & 31, h = lane >> 5;
  const int lrow = tid >> 3, lkc = (tid & 7) * 8;
  const u16* ag = A + (size_t)(m0 + lrow) * lda + lkc;
  const u16* bg = Bt + (size_t)(n0 + lrow) * K + lkc;
  u32x4 ra[4], rb[2];
  float ssq[4] = {0.f, 0.f, 0.f, 0.f};
  f32x16 acc[2][2];
#pragma unroll
  for (int i = 0; i < 2; ++i)
#pragma unroll
    for (int j = 0; j < 2; ++j)
#pragma unroll
      for (int e = 0; e < 16; ++e) acc[i][j][e] = 0.f;
  const int nk = K / 64;
  auto gload = [&](int kt) {
#pragma unroll
    for (int i = 0; i < 4; ++i) ra[i] = *(const u32x4*)(ag + (size_t)(64 * i) * lda + kt * 64);
#pragma unroll
    for (int i = 0; i < 2; ++i) rb[i] = *(const u32x4*)(bg + (size_t)(64 * i) * K + kt * 64);
  };
  auto lstore = [&](int buf) {
    u16* as = As + buf * 256 * GA_ST; u16* bs = Bs + buf * 128 * GA_ST;
#pragma unroll
    for (int i = 0; i < 4; ++i) {
      *(u32x4*)(as + (lrow + 64 * i) * GA_ST + lkc) = ra[i];
      if constexpr (ROWNORM) { float f[8]; unpack8(ra[i], f);
#pragma unroll
        for (int e = 0; e < 8; ++e) ssq[i] += f[e] * f[e]; }
    }
#pragma unroll
    for (int i = 0; i < 2; ++i) *(u32x4*)(bs + (lrow + 64 * i) * GA_ST + lkc) = rb[i];
  };
  gload(0); lstore(0);
  __syncthreads();
  for (int kt = 0; kt < nk; ++kt) {
    const int buf = kt & 1;
    if (kt + 1 < nk) gload(kt + 1);
    const u16* as = As + buf * 256 * GA_ST + (wm * 64 + r) * GA_ST + h * 8;
    const u16* bs = Bs + buf * 128 * GA_ST + (wn * 64 + r) * GA_ST + h * 8;
#pragma unroll
    for (int ks = 0; ks < 4; ++ks) {
      const bf16x8 a0 = ld_frag16(as + ks * 16), a1 = ld_frag16(as + 32 * GA_ST + ks * 16);
      const bf16x8 b0 = ld_frag16(bs + ks * 16), b1 = ld_frag16(bs + 32 * GA_ST + ks * 16);
      acc[0][0] = MFMA32(b0, a0, acc[0][0]); acc[0][1] = MFMA32(b1, a0, acc[0][1]);
      acc[1][0] = MFMA32(b0, a1, acc[1][0]); acc[1][1] = MFMA32(b1, a1, acc[1][1]);
    }
    if constexpr (GROUPS) {
      if ((kt & 7) == 7) {
        const int g = kt >> 3;
        const float* ss = (const float*)(p.ws + OFF_SS);
#pragma unroll
        for (int mi = 0; mi < 2; ++mi) {
          const int row = m0 + wm * 64 + mi * 32 + r;
          const float sg = rsqrtf(ss[(size_t)row * 4 + g] * (1.0f / 512.0f) + 1e-6f);
          float sc = sg;
          if (g < 3) sc = sg * sqrtf(ss[(size_t)row * 4 + g + 1] * (1.0f / 512.0f) + 1e-6f);
#pragma unroll
          for (int ni = 0; ni < 2; ++ni)
#pragma unroll
            for (int e = 0; e < 16; ++e) acc[mi][ni][e] *= sc;
        }
      }
    }
    if (kt + 1 < nk) lstore(buf ^ 1);
    __syncthreads();
  }
  float rsv[2] = {1.f, 1.f};
  if constexpr (ROWNORM) {
#pragma unroll
    for (int i = 0; i < 4; ++i) {
      float s = ssq[i];
      s += __shfl_xor(s, 1); s += __shfl_xor(s, 2); s += __shfl_xor(s, 4);
      if ((tid & 7) == 0) ssrow[lrow + 64 * i] = s;
    }
    __syncthreads();
#pragma unroll
    for (int mi = 0; mi < 2; ++mi) rsv[mi] = rsqrtf(ssrow[wm * 64 + mi * 32 + r] / (float)K + 1e-6f);
  }
#pragma unroll
  for (int mi = 0; mi < 2; ++mi)
#pragma unroll
    for (int ni = 0; ni < 2; ++ni) {
      const int row = m0 + wm * 64 + mi * 32 + r, colbase = n0 + wn * 64 + ni * 32;
      gemm_epi<MODE>(p, row, colbase, h, acc[mi][ni], rsv[mi]);
    }
  __syncthreads();
}

template <int MODE>
DI void gemm_phase(const Params& p, const u16* A, int lda, const u16* Bt, int K, int Npad, int& rot, char* smem) {
  const int nN = Npad / 128, n = (T / 256) * nN, nb = gridDim.x;
  for (int it = (blockIdx.x + nb - rot) % nb; it < n; it += nb) gemm_tile<MODE>(p, A, lda, Bt, K, (it / nN) * 256, (it % nN) * 128, smem);
  rot = (rot + n) % nb;
}

namespace pg8 {
#define PG8_LAS __attribute__((address_space(3)))
typedef unsigned short bf16_t;
typedef short bf16x8 __attribute__((ext_vector_type(8)));
typedef float f32x4 __attribute__((ext_vector_type(4)));
typedef unsigned u32x4 __attribute__((ext_vector_type(4)));
constexpr int BM = 256, BK = 64, HALF = 128, HTB = HALF * BK * 2  , STAGE_BYTES = 8 * HTB, NXCD = 8, WGM = 8;

__host__ __device__ __forceinline__ int lds_byte(int r, int c) { const int st = (r >> 4) * 2 + (c >> 5), rr = r & 15, cc = c & 31, ob = rr * 64 + cc * 2; return st * 1024 + (ob ^ (((ob >> 9) & 1) << 5)); }
__host__ __device__ __forceinline__ void stage_rc(int b, int& R, int& C) { const int st = b / 1024, sb = b % 1024, swz = sb ^ (((sb >> 9) & 1) << 5); R = (st >> 1) * 16 + swz / 64; C = (st & 1) * 32 + (swz % 64) / 2; }
__host__ __device__ __forceinline__ int perm32(int rho) { const int n = rho >> 4, i = rho & 15; return 8 * (i >> 2) + 4 * n + (i & 3); }

struct Unit { int pm, pn; };
struct Gemm { const bf16_t* A; const bf16_t* Bt; int M, N, K, lda; };

struct StaticOrder {
    int nM, nN, nwg, G, c;
    __host__ __device__ void init(int M, int N, int G_, int c_) { nM = M / BM; nN = N / BM; nwg = nM * nN; G = G_; c = c_; }
    __host__ __device__ bool next(int i, Unit& u) const {
        const long L = (long)i * G + c; if (L >= nwg) return false;
        int wgid = (int)L; { const int q = nwg / NXCD, r = nwg % NXCD, xcd = wgid % NXCD, off = wgid / NXCD; wgid = (xcd < r ? xcd * (q + 1) : r * (q + 1) + (xcd - r) * q) + off; }
        const int nig = WGM * nN, gid = wgid / nig, fm = gid * WGM, gsz = (nM - fm) < WGM ? (nM - fm) : WGM;
        u.pm = fm + ((wgid % nig) % gsz); u.pn = (wgid % nig) / gsz; return true;
    }
    __device__ __forceinline__ void a_ready(const Unit&) const {}
    __device__ __forceinline__ void done(const Unit&) const {}
};
template <class Epi, class Sched, bool STAMP = false>
__device__ __forceinline__ void gemm_phase(PG8_LAS unsigned char* lds, const Gemm g, const Sched& S, const Epi& E, unsigned long long* stamps) {
    const int tid = tid_(), wid = __builtin_amdgcn_readfirstlane(tid >> 6), lane = tid & 63, wr = wid >> 2, wc = wid & 3, fr = lane & 15, fq = lane >> 4;
    const int K = g.K, nt = K / BK;
    int ts_lo = 0, ts_hi = 0, nts = 0; const unsigned long long rt_entry = STAMP ? (unsigned long long)wall_clock64() : 0ull;
#define PG8_STAMP() do { if (STAMP && wid == 0 && nts < 64) { const unsigned long long _c = (unsigned long long)clock64(); \
        ts_lo = (lane == nts) ? (int)(unsigned)_c : ts_lo; ts_hi = (lane == nts) ? (int)(unsigned)(_c >> 32) : ts_hi; ++nts; } } while (0)
    PG8_STAMP();
    unsigned voffA[2], voffB[2];
#pragma unroll
    for (int i = 0; i < 2; ++i) { int R, C; stage_rc(tid * 16 + i * 8192, R, C); const int Rb = Epi::PERM ? ((R & ~31) + perm32(R & 31)) : R;
        voffA[i] = (unsigned)(R * g.lda + C) * 2u; voffB[i] = (unsigned)(Rb * K + C) * 2u; }
    const size_t kstep = (size_t)(BK * 2);
    const size_t hstepA = (size_t)HALF * g.lda * 2, hstepB = (size_t)HALF * K * 2;
    const size_t tstepA = 2 * hstepA, tstepB = 2 * hstepB;
    const unsigned ldsw = (unsigned)wid * 1024u;
    const int aoff = lds_byte(wr * 64 + fr, fq * 8), boff = lds_byte(wc * 32 + fr, fq * 8);
#define PG8_SA(b, h) (((b) * 2 + (h)) * HTB)
#define PG8_SB(b, h) ((4 + (b) * 2 + (h)) * HTB)
#define PG8_STAGE(bufoff, gbase, voff) do { _Pragma("unroll") for (int _i = 0; _i < 2; ++_i) \
        __builtin_amdgcn_global_load_lds((const unsigned*)((const char*)(gbase) + (voff)[_i]), (PG8_LAS unsigned*)(lds + (bufoff) + ldsw + _i * 8192), 16, 0, 0); } while (0)
#define PG8_LDA(dst, b, h) do { _Pragma("unroll") for (int m = 0; m < 4; ++m) _Pragma("unroll") for (int k = 0; k < 2; ++k) dst[m][k] = *(const PG8_LAS bf16x8*)(lds + PG8_SA(b, h) + aoff + m * 2048 + k * 1024); } while (0)
#define PG8_LDB(dst, b, h) do { _Pragma("unroll") for (int n = 0; n < 2; ++n) _Pragma("unroll") for (int k = 0; k < 2; ++k) dst[n][k] = *(const PG8_LAS bf16x8*)(lds + PG8_SB(b, h) + boff + n * 2048 + k * 1024); } while (0)
#define PG8_MMA(ai, bj, At, Bt) do { __builtin_amdgcn_s_setprio(1); _Pragma("unroll") for (int m = 0; m < 4; ++m) _Pragma("unroll") for (int n = 0; n < 2; ++n) _Pragma("unroll") for (int k = 0; k < 2; ++k) \
        acc[ai][bj][m][n] = __builtin_amdgcn_mfma_f32_16x16x32_bf16(Bt[n][k], At[m][k], acc[ai][bj][m][n], 0, 0, 0); __builtin_amdgcn_s_setprio(0); } while (0)
#define PG8_WAIT_V(n) asm volatile("s_waitcnt vmcnt(" #n ")" ::: "memory")
#define PG8_WAIT_L(n) asm volatile("s_waitcnt lgkmcnt(" #n ")" ::: "memory")
#define PG8_BAR __builtin_amdgcn_s_barrier()
#define PG8_SCHED __builtin_amdgcn_sched_barrier(0)
    Unit cur, nxt; int ui = 0;
    if (!S.next(0, cur)) return;
    f32x4 acc[2][2][4][2];
#pragma unroll
    for (int a = 0; a < 2; ++a)
#pragma unroll
        for (int b = 0; b < 2; ++b)
#pragma unroll
            for (int m = 0; m < 4; ++m)
#pragma unroll
                for (int n = 0; n < 2; ++n) acc[a][b][m][n] = (f32x4){0.f, 0.f, 0.f, 0.f};
    bf16x8 At[4][2], B0[2][2], B1[2][2];
    const char* cA = (const char*)g.A + (size_t)cur.pm * tstepA; const char* cB = (const char*)g.Bt + (size_t)cur.pn * tstepB;
    S.a_ready(cur);
    PG8_STAGE(PG8_SB(0, 0), cB, voffB); PG8_STAGE(PG8_SA(0, 0), cA, voffA); PG8_STAGE(PG8_SB(0, 1), cB + hstepB, voffB); PG8_STAGE(PG8_SA(0, 1), cA + hstepA, voffA);
    if (wr == 1) PG8_BAR;
    PG8_WAIT_V(4); PG8_BAR;
    PG8_STAGE(PG8_SB(1, 0), cB + kstep, voffB); PG8_STAGE(PG8_SA(1, 0), cA + kstep, voffA); PG8_STAGE(PG8_SB(1, 1), cB + hstepB + kstep, voffB);
    PG8_WAIT_V(6); PG8_BAR;
    PG8_STAMP();
    for (;;) {
        const bool has_next = S.next(ui + 1, nxt);
        const char* nA = has_next ? (const char*)g.A + (size_t)nxt.pm * tstepA : cA; const char* nB = has_next ? (const char*)g.Bt + (size_t)nxt.pn * tstepB : cB;
        for (int t = 0; t < nt; t += 2) {
            const bool last = (t == nt - 2);
            const char* a1 = cA + (size_t)(t + 1) * kstep;
            const char* a2 = last ? nA : cA + (size_t)(t + 2) * kstep; const char* b2 = last ? nB : cB + (size_t)(t + 2) * kstep;
            const char* a3 = a2 + kstep; const char* b3 = b2 + kstep;
            if (last && has_next) S.a_ready(nxt);
            PG8_LDB(B0, 0, 0); PG8_SCHED; PG8_LDA(At, 0, 0); PG8_STAGE(PG8_SA(1, 1), a1 + hstepA, voffA);
            PG8_WAIT_L(8); PG8_BAR; PG8_WAIT_L(0); PG8_MMA(0, 0, At, B0); PG8_BAR; PG8_SCHED;
            PG8_LDB(B1, 0, 1); PG8_STAGE(PG8_SB(0, 0), b2, voffB);
            PG8_BAR; PG8_WAIT_L(0); PG8_MMA(0, 1, At, B1); PG8_BAR;
            PG8_LDA(At, 0, 1); PG8_STAGE(PG8_SA(0, 0), a2, voffA);
            PG8_BAR; PG8_WAIT_L(0); PG8_MMA(1, 0, At, B0); PG8_BAR; PG8_SCHED;
            PG8_STAGE(PG8_SB(0, 1), b2 + hstepB, voffB);
            PG8_WAIT_V(6); PG8_BAR; PG8_MMA(1, 1, At, B1); PG8_BAR;
            PG8_LDB(B0, 1, 0); PG8_SCHED; PG8_LDA(At, 1, 0); PG8_STAGE(PG8_SA(0, 1), a2 + hstepA, voffA);
            PG8_WAIT_L(8); PG8_BAR; PG8_WAIT_L(0); PG8_MMA(0, 0, At, B0); PG8_BAR; PG8_SCHED;
            PG8_LDB(B1, 1, 1); PG8_STAGE(PG8_SB(1, 0), b3, voffB);
            PG8_BAR; PG8_WAIT_L(0); PG8_MMA(0, 1, At, B1); PG8_BAR;
            PG8_LDA(At, 1, 1); PG8_STAGE(PG8_SA(1, 0), a3, voffA);
            PG8_BAR; PG8_WAIT_L(0); PG8_MMA(1, 0, At, B0); PG8_BAR; PG8_SCHED;
            PG8_STAGE(PG8_SB(1, 1), b3 + hstepB, voffB);
            PG8_WAIT_V(6); PG8_BAR; PG8_MMA(1, 1, At, B1); PG8_BAR;
            if constexpr (Epi::KHOOK) { if (((t + 2) & 7) == 0) E.khook(acc, cur, ((t + 2) >> 3) - 1, wr, wc, fr, fq); }
        }
        PG8_STAMP();
        if constexpr (!Epi::AFTER_DRAIN) { E(acc, cur, wr, wc, fr, fq); S.done(cur); }
        PG8_STAMP();
        if (!has_next) break;
#pragma unroll
        for (int a = 0; a < 2; ++a)
#pragma unroll
            for (int b = 0; b < 2; ++b)
#pragma unroll
                for (int m = 0; m < 4; ++m)
#pragma unroll
                    for (int n = 0; n < 2; ++n) acc[a][b][m][n] = (f32x4){0.f, 0.f, 0.f, 0.f};
        cur = nxt; cA = nA; cB = nB; ++ui;
    }
    PG8_WAIT_V(0);
    if (wr == 0) PG8_BAR;
    PG8_BAR;
    if constexpr (Epi::AFTER_DRAIN) { E.fused(acc, cur, wr, wc, fr, fq, lds, wid, lane); S.done(cur); }
    PG8_STAMP();
    if (STAMP && wid == 0) { stamps[lane] = lane < nts ? (((unsigned long long)(unsigned)ts_hi << 32) | (unsigned)ts_lo) : 0ull;
        if (lane == 62) stamps[62] = rt_entry; if (lane == 63) stamps[63] = (unsigned long long)wall_clock64(); }
#undef PG8_STAMP
#undef PG8_SA
#undef PG8_SB
#undef PG8_STAGE
#undef PG8_LDA
#undef PG8_LDB
#undef PG8_MMA
#undef PG8_WAIT_V
#undef PG8_WAIT_L
#undef PG8_BAR
#undef PG8_SCHED
}
}

struct EpiProj0 {
  static constexpr bool PERM = true, AFTER_DRAIN = false, KHOOK = false;
  u16* O;
  DI void operator()(const f32x4 (&acc)[2][2][4][2], const pg8::Unit& u, int wr, int wc, int fr, int fq) const {
    const int row0 = u.pm * 256 + wr * 64 + fr;
#pragma unroll
    for (int ai = 0; ai < 2; ++ai)
#pragma unroll
      for (int m = 0; m < 4; ++m) {
        u16* rowp = O + (size_t)(row0 + ai * 128 + m * 16) * LD0;
#pragma unroll
        for (int bj = 0; bj < 2; ++bj) {
          const int colb = u.pn * 256 + bj * 128;
          f32x4 v0 = acc[ai][bj][m][0], v1 = acc[ai][bj][m][1];
          if (colb >= 512 && colb < 1536) {
#pragma unroll
            for (int e = 0; e < 4; ++e) { v0[e] = siluf_(v0[e]); v1[e] = siluf_(v1[e]); }
          }
          u32x4 w; w.x = pk2(v0[0], v0[1]); w.y = pk2(v0[2], v0[3]); w.z = pk2(v1[0], v1[1]); w.w = pk2(v1[2], v1[3]);
          *(u32x4*)(rowp + colb + wc * 32 + 8 * fq) = w;
        }
      }
  }
};
struct EpiProj1 {
  static constexpr bool PERM = true, AFTER_DRAIN = false, KHOOK = false;
  u16* O; float* dt; const float* dt_bias;
  DI void operator()(const f32x4 (&acc)[2][2][4][2], const pg8::Unit& u, int wr, int wc, int fr, int fq) const {
    const int row0 = u.pm * 256 + wr * 64 + fr;
#pragma unroll
    for (int ai = 0; ai < 2; ++ai)
#pragma unroll
      for (int m = 0; m < 4; ++m) {
        const int row = row0 + ai * 128 + m * 16;
        u16* rowp = O + (size_t)row * LD1;
#pragma unroll
        for (int bj = 0; bj < 2; ++bj) {
          const int colb = u.pn * 256 + bj * 128;
          f32x4 v0 = acc[ai][bj][m][0], v1 = acc[ai][bj][m][1];
          if (colb < 5120) {
            if (colb < 2048) {
#pragma unroll
              for (int e = 0; e < 4; ++e) { v0[e] = siluf_(v0[e]); v1[e] = siluf_(v1[e]); }
            }
            u32x4 w; w.x = pk2(v0[0], v0[1]); w.y = pk2(v0[2], v0[3]); w.z = pk2(v1[0], v1[1]); w.w = pk2(v1[2], v1[3]);
            *(u32x4*)(rowp + colb + wc * 32 + 8 * fq) = w;
          } else if (colb == 5120 && wc == 0) {
            *(f32x4*)(dt + (size_t)row * 32 + 8 * fq) = v0; *(f32x4*)(dt + (size_t)row * 32 + 8 * fq + 4) = v1;
          }
        }
      }
  }
};
template <bool HOOK> struct EpiResid {
  static constexpr bool PERM = false, AFTER_DRAIN = false, KHOOK = HOOK;
  const float* src; float* dst; const float* ss;
  DI void khook(f32x4 (&acc)[2][2][4][2], const pg8::Unit& u, int g, int wr, int wc, int fr, int fq) const {
    const int row0 = u.pm * 256 + wr * 64 + fr;
    float sc[2][4];
#pragma unroll
    for (int ai = 0; ai < 2; ++ai)
#pragma unroll
      for (int m = 0; m < 4; ++m) {
        const float* sp = ss + (size_t)(row0 + ai * 128 + m * 16) * 4;
        const float a = sp[g], b = sp[(g < 3) ? g + 1 : g];
        float s = rsqrtf(a * (1.0f / 512.0f) + 1e-6f);
        if (g < 3) s *= sqrtf(b * (1.0f / 512.0f) + 1e-6f);
        sc[ai][m] = s;
      }
    asm volatile("s_waitcnt vmcnt(0)" ::: "memory");
#pragma unroll
    for (int ai = 0; ai < 2; ++ai)
#pragma unroll
      for (int m = 0; m < 4; ++m)
#pragma unroll
        for (int bj = 0; bj < 2; ++bj)
#pragma unroll
          for (int n = 0; n < 2; ++n) acc[ai][bj][m][n] *= sc[ai][m];
  }
  DI void operator()(const f32x4 (&acc)[2][2][4][2], const pg8::Unit& u, int wr, int wc, int fr, int fq) const {
    const int row0 = u.pm * 256 + wr * 64 + fr, col0 = u.pn * 256 + wc * 32 + 4 * fq;
#pragma unroll
    for (int ai = 0; ai < 2; ++ai)
#pragma unroll
      for (int m = 0; m < 4; ++m) {
        const size_t ro = (size_t)(row0 + ai * 128 + m * 16) * 1024 + col0;
#pragma unroll
        for (int bj = 0; bj < 2; ++bj)
#pragma unroll
          for (int n = 0; n < 2; ++n) {
            const f32x4 xv = *(const f32x4*)(src + ro + bj * 128 + n * 16);
            *(f32x4*)(dst + ro + bj * 128 + n * 16) = xv * DN_ALPHA + acc[ai][bj][m][n];
          }
      }
  }
};
template <class Epi>
DI void pg8_run(const u16* A, int lda, const u16* Bt, int N, int K, const Epi& E, char* smem) {
  pg8::Gemm g; g.A = A; g.Bt = Bt; g.M = T; g.N = N; g.K = K; g.lda = lda;
  pg8::StaticOrder S; S.init(T, N, (int)gridDim.x, (int)blockIdx.x);
  pg8::gemm_phase<Epi, pg8::StaticOrder, false>((PG8_LAS unsigned char*)smem, g, S, E, nullptr);
  __syncthreads();
}

DI float neg_expm1(float x) {
  if (x > -0.1f) return -x * (1.0f + x * (0.5f + x * ((1.0f / 6.0f) + x * ((1.0f / 24.0f) + x * (1.0f / 120.0f)))));
  return 1.0f - fast_exp(x);
}
DI void rglru_item(const Params& p, int item, char* smem) {
  char* ws = p.ws;
  const int hd = item & 7, bc = item >> 3, c = bc & 31, b = bc >> 5;
  const int t0 = b * SEQ + c * 128, s0 = c * 128;
  u16* Xc = (u16*)smem;
  u16* Was = (u16*)(smem + 18432);
  u16* Wxs = (u16*)(smem + 18432 + 9216);
  float* Xf = (float*)(smem + 36864);
  float* tend = (float*)(smem + 36864 + 33280);
  const int tid = tid_(), lane = tid & 63, w = tid >> 6, r = lane & 31, h = lane >> 5;
  const u16* proj0 = (const u16*)(ws + OFF_PROJ0);
  {
    const int cc = (tid & 7) * 8, ch = hd * 64 + cc;
    float cw[4][8], cb[8];
#pragma unroll
    for (int k = 0; k < 4; ++k)
#pragma unroll
      for (int e = 0; e < 8; ++e) cw[k][e] = p.ab_conv_w[k * 512 + ch + e];
#pragma unroll
    for (int e = 0; e < 8; ++e) cb[e] = p.ab_conv_b[ch + e];
#pragma unroll
    for (int i = 0; i < 2; ++i) {
      const int l = (tid >> 3) + 64 * i;
      float xc[8];
#pragma unroll
      for (int e = 0; e < 8; ++e) xc[e] = cb[e];
#pragma unroll
      for (int k = 0; k < 4; ++k) {
        const int s = s0 + l - 3 + k;
        if (s >= 0) {
          const u32x4 v = *(const u32x4*)(proj0 + (size_t)(t0 + l - 3 + k) * LD0 + ch);
          float f[8]; unpack8(v, f);
#pragma unroll
          for (int e = 0; e < 8; ++e) xc[e] += cw[k][e] * f[e];
        }
      }
      *(u32x4*)(Xc + l * GA_ST + cc) = pack8(xc);
#pragma unroll
      for (int e = 0; e < 8; ++e) Xf[l * 65 + cc + e] = xc[e];
    }
    const int j = tid >> 3;
    *(u32x4*)(Was + j * GA_ST + cc) = *(const u32x4*)((const u16*)(ws + OFF_WAT) + hd * 4096 + j * 64 + cc);
    *(u32x4*)(Wxs + j * GA_ST + cc) = *(const u32x4*)((const u16*)(ws + OFF_WXT) + hd * 4096 + j * 64 + cc);
  }
  __syncthreads();
  const int lt = w & 3, jt = w >> 2;
  f32x16 accA, accX;
#pragma unroll
  for (int e = 0; e < 16; ++e) { accA[e] = 0.f; accX[e] = 0.f; }
#pragma unroll
  for (int ks = 0; ks < 4; ++ks) {
    const bf16x8 af = ld_frag16(Xc + (lt * 32 + r) * GA_ST + ks * 16 + h * 8);
    const bf16x8 ba = ld_frag16(Was + (jt * 32 + r) * GA_ST + ks * 16 + h * 8);
    const bf16x8 bx = ld_frag16(Wxs + (jt * 32 + r) * GA_ST + ks * 16 + h * 8);
    accA = MFMA32(ba, af, accA); accX = MFMA32(bx, af, accX);
  }
  float Av[16], Bv[16];
#pragma unroll
  for (int i = 0; i < 16; ++i) {
    const int j = jt * 32 + crow(i, h), chg = hd * 64 + j;
    const float ra_ = sigmoidf_(accA[i] + p.ga_b[chg]);
    const float ix = sigmoidf_(accX[i] + p.gx_b[chg]);
    const float sp = log1pf(expf(-p.lam[chg]));
    const float log_a = -8.0f * ra_ * sp;
    Av[i] = fast_exp(log_a);
    const float mult = sqrtf(neg_expm1(2.0f * log_a));
    Bv[i] = mult * ix * Xf[(lt * 32 + r) * 65 + j];
  }
#pragma unroll
  for (int d = 1; d < 32; d <<= 1) {
#pragma unroll
    for (int i = 0; i < 16; ++i) {
      const float Ap = __shfl_up(Av[i], d, 32), Bp = __shfl_up(Bv[i], d, 32);
      if (r >= d) { Bv[i] = Av[i] * Bp + Bv[i]; Av[i] = Av[i] * Ap; }
    }
  }
  if (r == 31) {
#pragma unroll
    for (int i = 0; i < 16; ++i) { const int j = jt * 32 + crow(i, h); tend[(lt * 64 + j) * 2] = Av[i]; tend[(lt * 64 + j) * 2 + 1] = Bv[i]; }
  }
  __syncthreads();
  const int t = t0 + lt * 32 + r;
  u16* hl = (u16*)(ws + OFF_HLOC) + (size_t)t * 512 + hd * 64;
  u16* pc = (u16*)(ws + OFF_PCUM) + (size_t)t * 512 + hd * 64;
  float hf[16], pf[16];
#pragma unroll
  for (int i = 0; i < 16; ++i) {
    const int j = jt * 32 + crow(i, h);
    float Hc = 0.f, Pp = 1.f;
    for (int tp = 0; tp < lt; ++tp) { const float Pe = tend[(tp * 64 + j) * 2], He = tend[(tp * 64 + j) * 2 + 1]; Hc = Pe * Hc + He; Pp *= Pe; }
    hf[i] = Bv[i] + Av[i] * Hc; pf[i] = Av[i] * Pp;
  }
#pragma unroll
  for (int g = 0; g < 4; ++g) {
    const int j = jt * 32 + 8 * g + 4 * h;
    u32x2 o; o.x = pk2(hf[4 * g], hf[4 * g + 1]); o.y = pk2(hf[4 * g + 2], hf[4 * g + 3]);
    *(u32x2*)(hl + j) = o;
    o.x = pk2(pf[4 * g], pf[4 * g + 1]); o.y = pk2(pf[4 * g + 2], pf[4 * g + 3]);
    *(u32x2*)(pc + j) = o;
  }
  if (lt == 3 && r == 31) {
    float* he = (float*)(ws + OFF_HEND) + (size_t)(b * 32 + c) * 512 + hd * 64;
    float* pe = (float*)(ws + OFF_PEND) + (size_t)(b * 32 + c) * 512 + hd * 64;
#pragma unroll
    for (int i = 0; i < 16; ++i) { const int j = jt * 32 + crow(i, h); he[j] = hf[i]; pe[j] = pf[i]; }
  }
  __syncthreads();
}

DI void krope_item(const Params& p, int item) {
  char* ws = p.ws;
  const u16* proj0 = (const u16*)(ws + OFF_PROJ0);
  const float* ct = (const float*)(ws + OFF_COS); const float* st = (const float*)(ws + OFF_SIN);
  u16* kc = (u16*)(ws + OFF_KC);
#pragma unroll
  for (int i = 0; i < 8; ++i) {
    const int u = tid_() + NT * i, tl = u >> 4, j = u & 15, t = item * 256 + tl;
    const float x1 = bf2f(proj0[(size_t)t * LD0 + 1920 + j]), x2 = bf2f(proj0[(size_t)t * LD0 + 1936 + j]);
    const float c = ct[(size_t)t * 16 + j], s = st[(size_t)t * 16 + j];
    const u16 o1 = f2bf(x1 * c - x2 * s), o2 = f2bf(x2 * c + x1 * s);
#pragma unroll
    for (int hh = 0; hh < 8; ++hh) { kc[(size_t)t * 768 + hh * 96 + 64 + j] = o1; kc[(size_t)t * 768 + hh * 96 + 80 + j] = o2; }
  }
}

constexpr int KS_ST = 104, VS_ST = 72;
DI void attn_item(const Params& p, int bh, int qb, char* smem) {
  char* ws = p.ws;
  const int b = bh >> 3, hh = bh & 7;
  u16* Ks = (u16*)smem;
  u16* Vs = (u16*)(smem + 2 * 64 * KS_ST * 2);
  const int tid = tid_(), lane = tid & 63, w = tid >> 6, r = lane & 31, h = lane >> 5;
  const int q0 = qb * 256, qw = q0 + w * 32, sq = qw + r;
  const size_t t = (size_t)b * SEQ + sq;
  const u16* Q = (const u16*)(ws + OFF_Q);
  const u16* Kc = (const u16*)(ws + OFF_KC) + (size_t)b * SEQ * 768 + hh * 96;
  const u16* Vt = (const u16*)(ws + OFF_VT) + (size_t)bh * 64 * SEQ;
  bf16x8 qf[6];
#pragma unroll
  for (int s = 0; s < 6; ++s) qf[s] = ld_frag16(Q + t * 768 + hh * 96 + s * 16 + h * 8);
  f32x16 o0, o1;
#pragma unroll
  for (int e = 0; e < 16; ++e) { o0[e] = 0.f; o1[e] = 0.f; }
  float m = -1e30f, l = 0.f;
  const int nkt = 4 * (qb + 1);
  const int c0 = tid, c1 = tid + NT;
  const int kr0 = c0 / 12, kc0 = (c0 % 12) * 8, kr1 = c1 / 12, kc1 = (c1 % 12) * 8;
  const bool has1 = c1 < 768;
  const int vd = tid >> 3, vk = (tid & 7) * 8;
  u32x4 rk0, rk1, rv;
  auto gload = [&](int kt) {
    const int k0 = kt * 64;
    rk0 = *(const u32x4*)(Kc + (size_t)(k0 + kr0) * 768 + kc0);
    if (has1) rk1 = *(const u32x4*)(Kc + (size_t)(k0 + kr1) * 768 + kc1);
    rv = *(const u32x4*)(Vt + (size_t)vd * SEQ + k0 + vk);
  };
  auto lstore = [&](int buf) {
    u16* ks = Ks + buf * 64 * KS_ST; u16* vs = Vs + buf * 64 * VS_ST;
    *(u32x4*)(ks + kr0 * KS_ST + kc0) = rk0;
    if (has1) *(u32x4*)(ks + kr1 * KS_ST + kc1) = rk1;
    *(u32x4*)(vs + vd * VS_ST + vk) = rv;
  };
  gload(0); lstore(0);
  __syncthreads();
  for (int kt = 0; kt < nkt; ++kt) {
    const int buf = kt & 1, k0 = kt * 64;
    if (kt + 1 < nkt) gload(kt + 1);
    if (k0 <= qw + 31) {
      const u16* ks = Ks + buf * 64 * KS_ST; const u16* vs = Vs + buf * 64 * VS_ST;
      f32x16 st0, st1;
#pragma unroll
      for (int e = 0; e < 16; ++e) { st0[e] = 0.f; st1[e] = 0.f; }
#pragma unroll
      for (int s = 0; s < 6; ++s) {
        const bf16x8 k0f = ld_frag16(ks + r * KS_ST + s * 16 + h * 8);
        const bf16x8 k1f = ld_frag16(ks + (32 + r) * KS_ST + s * 16 + h * 8);
        st0 = MFMA32(k0f, qf[s], st0); st1 = MFMA32(k1f, qf[s], st1);
      }
      if (k0 + 63 > qw) {
#pragma unroll
        for (int i = 0; i < 16; ++i) {
          const int key = k0 + crow(i, h);
          if (key > sq) st0[i] = -1e30f;
          if (key + 32 > sq) st1[i] = -1e30f;
        }
      }
      float mx = st0[0];
#pragma unroll
      for (int i = 1; i < 16; ++i) mx = fmaxf(mx, st0[i]);
#pragma unroll
      for (int i = 0; i < 16; ++i) mx = fmaxf(mx, st1[i]);
      mx = fmaxf(mx, __shfl_xor(mx, 32));
      const float mn = fmaxf(m, mx), alpha = fast_exp2(m - mn);
      float ls = 0.f;
#pragma unroll
      for (int i = 0; i < 16; ++i) { st0[i] = fast_exp2(st0[i] - mn); st1[i] = fast_exp2(st1[i] - mn); ls += st0[i] + st1[i]; }
      l = l * alpha + ls; m = mn;
#pragma unroll
      for (int e = 0; e < 16; ++e) { o0[e] *= alpha; o1[e] *= alpha; }
#pragma unroll
      for (int s = 0; s < 2; ++s) {
        const bf16x8 p0 = pack_frag(st0, s), p1 = pack_frag(st1, s);
        {
          const u16* v0 = vs + r * VS_ST + 16 * s + 4 * h;
          const bf16x8 va = ld_frag8x2(v0, v0 + 8), vb = ld_frag8x2(v0 + 32 * VS_ST, v0 + 32 * VS_ST + 8);
          o0 = MFMA32(va, p0, o0); o1 = MFMA32(vb, p0, o1);
        }
        {
          const u16* v1 = vs + r * VS_ST + 32 + 16 * s + 4 * h;
          const bf16x8 va = ld_frag8x2(v1, v1 + 8), vb = ld_frag8x2(v1 + 32 * VS_ST, v1 + 32 * VS_ST + 8);
          o0 = MFMA32(va, p1, o0); o1 = MFMA32(vb, p1, o1);
        }
      }
    }
    if (kt + 1 < nkt) lstore(buf ^ 1);
    __syncthreads();
  }
  const float lt = l + __shfl_xor(l, 32), inv = 1.0f / lt;
  const u16* sg = (const u16*)(ws + OFF_PROJ0) + t * LD0 + 1024 + hh * 64;
  u16* yc = (u16*)(ws + OFF_YCAT) + t * 1024 + 512 + hh * 64;
#pragma unroll
  for (int dt = 0; dt < 2; ++dt)
#pragma unroll
    for (int g = 0; g < 4; ++g) {
      const int d = dt * 32 + 8 * g + 4 * h;
      const u32x2 gv = *(const u32x2*)(sg + d);
      const f32x16& o = dt ? o1 : o0;
      u32x2 ov;
      ov.x = pk2(o[4 * g] * inv * bflo(gv.x), o[4 * g + 1] * inv * bfhi(gv.x));
      ov.y = pk2(o[4 * g + 2] * inv * bflo(gv.y), o[4 * g + 3] * inv * bfhi(gv.y));
      *(u32x2*)(yc + d) = ov;
    }
}

DI void fixup_item(const Params& p, int item, char* smem) {
  char* ws = p.ws;
  const int b = item >> 5, c = item & 31, tid = tid_();
  float* Hin = (float*)smem;
  {
    const float* he = (const float*)(ws + OFF_HEND) + (size_t)(b * 32) * 512 + tid;
    const float* pe = (const float*)(ws + OFF_PEND) + (size_t)(b * 32) * 512 + tid;
    float H = 0.f;
    for (int cp = 0; cp < c; ++cp) H = pe[cp * 512] * H + he[cp * 512];
    Hin[tid] = H;
  }
  __syncthreads();
  const size_t t0 = (size_t)b * SEQ + c * 128;
  const u16* hl = (const u16*)(ws + OFF_HLOC); const u16* pc = (const u16*)(ws + OFF_PCUM);
  const u16* proj0 = (const u16*)(ws + OFF_PROJ0); u16* yc = (u16*)(ws + OFF_YCAT);
#pragma unroll 4
  for (int i = 0; i < 16; ++i) {
    const int u = tid + NT * i, l = u >> 6, cc = (u & 63) * 8;
    const size_t tt = t0 + l;
    const u32x4 hv = *(const u32x4*)(hl + tt * 512 + cc), pv = *(const u32x4*)(pc + tt * 512 + cc), gv = *(const u32x4*)(proj0 + tt * LD0 + 512 + cc);
    float hf[8], pf[8], gf[8], o[8];
    unpack8(hv, hf); unpack8(pv, pf); unpack8(gv, gf);
#pragma unroll
    for (int e = 0; e < 8; ++e) o[e] = (hf[e] + pf[e] * Hin[cc + e]) * gf[e];
    *(u32x4*)(yc + tt * 1024 + cc) = pack8(o);
  }
  __syncthreads();
}

DI void ln_phase(const Params& p, const float* __restrict__ g, const float* __restrict__ bta, u16* xb) {
  const int lane = tid_() & 63, gw = blockIdx.x * 8 + (tid_() >> 6), nw = gridDim.x * 8;
  f32x4 gg[4], bb[4];
#pragma unroll
  for (int i = 0; i < 4; ++i) { gg[i] = *(const f32x4*)(g + i * 256 + lane * 4); bb[i] = *(const f32x4*)(bta + i * 256 + lane * 4); }
  for (int row = gw; row < T; row += nw) {
    float* pr = p.out + (size_t)row * 1024;
    f32x4 v[4];
    float s = 0.f;
#pragma unroll
    for (int i = 0; i < 4; ++i) { v[i] = *(const f32x4*)(pr + i * 256 + lane * 4); s += (v[i].x + v[i].y) + (v[i].z + v[i].w); }
#pragma unroll
    for (int d = 1; d < 64; d <<= 1) s += __shfl_xor(s, d);
    const float mu = s * (1.0f / 1024.0f);
    float q = 0.f;
#pragma unroll
    for (int i = 0; i < 4; ++i) { v[i].x -= mu; v[i].y -= mu; v[i].z -= mu; v[i].w -= mu; q += (v[i].x * v[i].x + v[i].y * v[i].y) + (v[i].z * v[i].z + v[i].w * v[i].w); }
#pragma unroll
    for (int d = 1; d < 64; d <<= 1) q += __shfl_xor(q, d);
    const float rstd = rsqrtf(q * (1.0f / 1024.0f) + 1e-5f);
#pragma unroll
    for (int i = 0; i < 4; ++i) {
      f32x4 o;
      o.x = v[i].x * rstd * gg[i].x + bb[i].x; o.y = v[i].y * rstd * gg[i].y + bb[i].y; o.z = v[i].z * rstd * gg[i].z + bb[i].z; o.w = v[i].w * rstd * gg[i].w + bb[i].w;
      *(f32x4*)(pr + i * 256 + lane * 4) = o;
      if (xb) { u32x2 w; w.x = pk2(o.x, o.y); w.y = pk2(o.z, o.w); *(u32x2*)(xb + (size_t)row * 1024 + i * 256 + lane * 4) = w; }
    }
  }
}

DI void bcconv_phase(const Params& p) {
  char* ws = p.ws;
  const u16* proj1 = (const u16*)(ws + OFF_PROJ1); u16* bc = (u16*)(ws + OFF_BC);
  const size_t gid = (size_t)blockIdx.x * NT + tid_(), gstride = (size_t)gridDim.x * NT;
  const int j8 = (int)(gid & 127) * 8;
  float cw[4][8], cb[8];
#pragma unroll
  for (int k = 0; k < 4; ++k)
#pragma unroll
    for (int e = 0; e < 8; ++e) cw[k][e] = p.ssd_conv_w[k * 3072 + 2048 + j8 + e];
#pragma unroll
  for (int e = 0; e < 8; ++e) cb[e] = p.ssd_conv_b[2048 + j8 + e];
  for (size_t u = gid; u < (size_t)T * 128; u += gstride) {
    const size_t t = u >> 7; const int s = (int)(t & 4095);
    float a[8];
#pragma unroll
    for (int e = 0; e < 8; ++e) a[e] = cb[e];
#pragma unroll
    for (int k = 0; k < 4; ++k) {
      if (s - 3 + k >= 0) {
        const u32x4 v = *(const u32x4*)(proj1 + (t - 3 + k) * LD1 + 4096 + j8);
        float f[8]; unpack8(v, f);
#pragma unroll
        for (int e = 0; e < 8; ++e) a[e] += cw[k][e] * f[e];
      }
    }
#pragma unroll
    for (int e = 0; e < 8; ++e) a[e] = siluf_(a[e]);
    *(u32x4*)(bc + t * 1024 + j8) = pack8(a);
  }
}

DI void ygscale_phase(const Params& p) {
  char* ws = p.ws;
  u16* yg = (u16*)(ws + OFF_PROJ1); const float* ss = (const float*)(ws + OFF_SS);
  const size_t gid = (size_t)blockIdx.x * NT + tid_(), gstride = (size_t)gridDim.x * NT;
  for (size_t u = gid; u < (size_t)T * 256; u += gstride) {
    const size_t t = u >> 8; const int c8 = (int)(u & 255) * 8;
    const float rs = rsqrtf(ss[t * 4 + (c8 >> 9)] * (1.0f / 512.0f) + 1e-6f);
    u32x4* ptr = (u32x4*)(yg + t * LD1 + c8);
    float f[8]; unpack8(*ptr, f);
#pragma unroll
    for (int e = 0; e < 8; ++e) f[e] *= rs;
    *ptr = pack8(f);
  }
}

constexpr int SS_ST = 136;
DI void ssd_item(const Params& p, int item, char* smem) {
  char* ws = p.ws;
  const int b = item >> 5, hd = item & 31, g = hd >> 3;
  u16* Cs = (u16*)smem;
  u16* Bs = (u16*)(smem + 34816);
  u16* Bd = (u16*)(smem + 2 * 34816);
  u16* Xt = (u16*)(smem + 3 * 34816);
  u16* St = (u16*)(smem + 3 * 34816 + 17408);
  u16* Xs = (u16*)(smem + 3 * 34816 + 2 * 17408);
  float* cs = (float*)(smem + 3 * 34816 + 2 * 17408 + 18432);
  float* dts = cs + 128;
  const int tid = tid_(), lane = tid & 63, w = tid >> 6, r = lane & 31, h = lane >> 5;
  const float a_neg = -expf(p.a_log[hd]), Dh = p.ssd_d[hd], dtbias = p.dt_bias[hd];
  u16* proj1 = (u16*)(ws + OFF_PROJ1);
  const u16* bcg = (const u16*)(ws + OFF_BC);
  const float* dtb = (const float*)(ws + OFF_DT);
  float* ssb = (float*)(ws + OFF_SS);
  const int xcc = (tid & 7) * 8, xch = hd * 64 + xcc;
  float cw[4][8], cb[8];
#pragma unroll
  for (int k = 0; k < 4; ++k)
#pragma unroll
    for (int e = 0; e < 8; ++e) cw[k][e] = p.ssd_conv_w[k * 3072 + xch + e];
#pragma unroll
  for (int e = 0; e < 8; ++e) cb[e] = p.ssd_conv_b[xch + e];
  f32x16 stacc;
#pragma unroll
  for (int e = 0; e < 16; ++e) stacc[e] = 0.f;
  for (int i = tid; i < 64 * SS_ST / 2; i += NT) ((unsigned*)St)[i] = 0u;
  const int lt = (w < 4) ? w : 7 - w, pt = w >> 2, nt = w & 3;
  for (int c = 0; c < 32; ++c) {
    const size_t t0 = (size_t)b * SEQ + c * 128;
    if (w == 0) {
      const float r0 = dtb[(t0 + 2 * lane) * 32 + hd] + dtbias, r1 = dtb[(t0 + 2 * lane + 1) * 32 + hd] + dtbias;
      const float d0 = fmaxf(r0, 0.f) + log1pf(expf(-fabsf(r0))), d1 = fmaxf(r1, 0.f) + log1pf(expf(-fabsf(r1)));
      const float a0 = d0 * a_neg, a1 = d1 * a_neg;
      float s = a0 + a1;
#pragma unroll
      for (int d = 1; d < 64; d <<= 1) { const float o = __shfl_up(s, d, 64); if (lane >= d) s += o; }
      cs[2 * lane] = s - a1; cs[2 * lane + 1] = s;
      dts[2 * lane] = d0; dts[2 * lane + 1] = d1;
    }
    __syncthreads();
    const float csT = cs[127];
#pragma unroll
    for (int i = 0; i < 2; ++i) {
      const int l = (tid >> 3) + 64 * i;
      float xv[8];
#pragma unroll
      for (int e = 0; e < 8; ++e) xv[e] = cb[e];
#pragma unroll
      for (int k = 0; k < 4; ++k) {
        if (c * 128 + l - 3 + k >= 0) {
          const u32x4 v = *(const u32x4*)(proj1 + (t0 + l - 3 + k) * LD1 + 2048 + xch);
          float f[8]; unpack8(v, f);
#pragma unroll
          for (int e = 0; e < 8; ++e) xv[e] += cw[k][e] * f[e];
        }
      }
#pragma unroll
      for (int e = 0; e < 8; ++e) xv[e] = siluf_(xv[e]);
      *(u32x4*)(Xs + l * GA_ST + xcc) = pack8(xv);
      const float dl = dts[l];
#pragma unroll
      for (int e = 0; e < 8; ++e) Xt[(xcc + e) * SS_ST + l] = f2bf(xv[e] * dl);
    }
#pragma unroll
    for (int i = 0; i < 4; ++i) {
      const int u = tid + NT * i, l = u >> 4, cc = (u & 15) * 8;
      const u32x4 bv = *(const u32x4*)(bcg + (t0 + l) * 1024 + g * 128 + cc);
      const u32x4 cv = *(const u32x4*)(bcg + (t0 + l) * 1024 + 512 + g * 128 + cc);
      *(u32x4*)(Bs + l * SS_ST + cc) = bv;
      *(u32x4*)(Cs + l * SS_ST + cc) = cv;
      const float dec = fast_exp(csT - cs[l]);
      float f[8]; unpack8(bv, f);
#pragma unroll
      for (int e = 0; e < 8; ++e) Bd[(cc + e) * SS_ST + l] = f2bf(f[e] * dec);
    }
    __syncthreads();
    {
      const int l = lt * 32 + r;
      const float csl = cs[l];
      f32x16 yd, yo;
#pragma unroll
      for (int e = 0; e < 16; ++e) { yd[e] = 0.f; yo[e] = 0.f; }
      for (int st = 0; st <= lt; ++st) {
        f32x16 cb_;
#pragma unroll
        for (int e = 0; e < 16; ++e) cb_[e] = 0.f;
#pragma unroll
        for (int ks = 0; ks < 8; ++ks) {
          const bf16x8 bf = ld_frag16(Bs + (st * 32 + r) * SS_ST + ks * 16 + h * 8);
          const bf16x8 cf = ld_frag16(Cs + l * SS_ST + ks * 16 + h * 8);
          cb_ = MFMA32(bf, cf, cb_);
        }
#pragma unroll
        for (int i = 0; i < 16; ++i) {
          const int s = st * 32 + crow(i, h);
          const float dec = fast_exp(csl - cs[s]);
          cb_[i] = (s <= l) ? cb_[i] * dec : 0.f;
        }
#pragma unroll
        for (int s2 = 0; s2 < 2; ++s2) {
          const bf16x8 pf = pack_frag(cb_, s2);
          const u16* x0 = Xt + (pt * 32 + r) * SS_ST + st * 32 + 16 * s2 + 4 * h;
          const bf16x8 xf = ld_frag8x2(x0, x0 + 8);
          yd = MFMA32(xf, pf, yd);
        }
      }
#pragma unroll
      for (int ks = 0; ks < 8; ++ks) {
        const bf16x8 sf = ld_frag16(St + (pt * 32 + r) * SS_ST + ks * 16 + h * 8);
        const bf16x8 cf = ld_frag16(Cs + l * SS_ST + ks * 16 + h * 8);
        yo = MFMA32(sf, cf, yo);
      }
      const float el = fast_exp(csl);
      const size_t t = t0 + l;
      u16* zrow = proj1 + t * LD1 + hd * 64;
      float ssq = 0.f;
#pragma unroll
      for (int gq = 0; gq < 4; ++gq) {
        const int pb = pt * 32 + 8 * gq + 4 * h;
        const u32x2 xv = *(const u32x2*)(Xs + l * GA_ST + pb);
        const u32x2 zv = *(const u32x2*)(zrow + pb);
        const float y0 = (yd[4 * gq] + el * yo[4 * gq] + Dh * bflo(xv.x)) * bflo(zv.x);
        const float y1 = (yd[4 * gq + 1] + el * yo[4 * gq + 1] + Dh * bfhi(xv.x)) * bfhi(zv.x);
        const float y2 = (yd[4 * gq + 2] + el * yo[4 * gq + 2] + Dh * bflo(xv.y)) * bflo(zv.y);
        const float y3 = (yd[4 * gq + 3] + el * yo[4 * gq + 3] + Dh * bfhi(xv.y)) * bfhi(zv.y);
        ssq += (y0 * y0 + y1 * y1) + (y2 * y2 + y3 * y3);
        u32x2 ov; ov.x = pk2(y0, y1); ov.y = pk2(y2, y3);
        *(u32x2*)(zrow + pb) = ov;
      }
      ssq += __shfl_xor(ssq, 32);
      if (h == 0) atomicAdd(ssb + t * 4 + g, ssq);
    }
    {
      const float dT = fast_exp(csT);
#pragma unroll
      for (int e = 0; e < 16; ++e) stacc[e] *= dT;
#pragma unroll
      for (int ks = 0; ks < 8; ++ks) {
        const bf16x8 bf = ld_frag16(Bd + (nt * 32 + r) * SS_ST + ks * 16 + h * 8);
        const bf16x8 xf = ld_frag16(Xt + (pt * 32 + r) * SS_ST + ks * 16 + h * 8);
        stacc = MFMA32(bf, xf, stacc);
      }
    }
    __syncthreads();
#pragma unroll
    for (int gq = 0; gq < 4; ++gq) {
      u32x2 ov; ov.x = pk2(stacc[4 * gq], stacc[4 * gq + 1]); ov.y = pk2(stacc[4 * gq + 2], stacc[4 * gq + 3]);
      *(u32x2*)(St + (pt * 32 + r) * SS_ST + nt * 32 + 8 * gq + 4 * h) = ov;
    }
  }
  __syncthreads();
}

__global__ void __launch_bounds__(NT) fwd_megakernel(Params p) {
  __shared__ __attribute__((aligned(16))) char smem[160 * 1024];
  cg::grid_group grid = cg::this_grid();
  char* ws = p.ws;
  const int nb = gridDim.x, bid = blockIdx.x;
  int rot = 0;
  phase_prep(p, smem);
  grid.sync();
  { EpiProj0 E; E.O = (u16*)(ws + OFF_PROJ0); pg8_run((const u16*)(ws + OFF_XB), 1024, (const u16*)(ws + OFF_W1T), 2048, 1024, E, smem); }
  grid.sync();
  for (int it = (bid + nb - rot) % nb; it < 2048; it += nb) rglru_item(p, it, smem);
  rot = (rot + 2048) % nb;
  gemm_phase<2>(p, (const u16*)(ws + OFF_PROJ0) + 1536, LD0, (const u16*)(ws + OFF_WQT), 256, 768, rot, smem);
  gemm_phase<3>(p, (const u16*)(ws + OFF_PROJ0) + 1792, LD0, (const u16*)(ws + OFF_WKVT), 128, 1024, rot, smem);
  for (int it = (bid + nb - rot) % nb; it < 128; it += nb) krope_item(p, it);
  rot = (rot + 128) % nb;
  grid.sync();
  for (int it = bid; it < 1024; it += nb) {
    const int j = it & 255, i = it >> 8, g = j >> 6, bh = j & 63;
    const int qb = (i == 0) ? 15 - g : (i == 1) ? 8 + g : (i == 2) ? 7 - g : g;
    attn_item(p, bh, qb, smem);
  }
  for (int it = bid; it < 256; it += nb) fixup_item(p, it, smem);
  grid.sync();
  rot = 0;
  { EpiResid<false> E; E.src = p.x; E.dst = p.out; E.ss = nullptr; pg8_run((const u16*)(ws + OFF_YCAT), 1024, (const u16*)(ws + OFF_WOT), 1024, 1024, E, smem); }
  grid.sync();
  ln_phase(p, p.ab_ln_g, p.ab_ln_b, (u16*)(ws + OFF_X1B));
  grid.sync();
  rot = 0;
  { EpiProj1 E; E.O = (u16*)(ws + OFF_PROJ1); E.dt = (float*)(ws + OFF_DT); E.dt_bias = p.dt_bias; pg8_run((const u16*)(ws + OFF_X1B), 1024, (const u16*)(ws + OFF_W2T), 5376, 1024, E, smem); }
  grid.sync();
  bcconv_phase(p);
  grid.sync();
  for (int it = bid; it < 256; it += nb) ssd_item(p, it, smem);
  grid.sync();
  ygscale_phase(p);
  grid.sync();
  rot = 0;
  { EpiResid<false> E; E.src = p.out; E.dst = p.out; E.ss = nullptr; pg8_run((const u16*)(ws + OFF_PROJ1), LD1, (const u16*)(ws + OFF_W3T), 1024, 2048, E, smem); }
  grid.sync();
  ln_phase(p, p.ssd_ln_g, p.ssd_ln_b, nullptr);
}

extern "C" void kernel_launch(void* const* d_in, const int* in_sizes, int n_in, void* d_out, int out_size, void* d_ws, size_t ws_size, hipStream_t stream) {
  static int grid_blocks = 0;
  if (!grid_blocks) {
    int dev = 0, cus = 0, per_cu = 0;
    hipGetDevice(&dev);
    hipDeviceGetAttribute(&cus, hipDeviceAttributeMultiprocessorCount, dev);
    hipOccupancyMaxActiveBlocksPerMultiprocessor(&per_cu, fwd_megakernel, NT, 0);
    if (per_cu < 1) per_cu = 1;
    grid_blocks = cus * per_cu;
  }
  Params p{};
  p.x = (const float*)d_in[0]; p.pos = (const int*)d_in[1];
  p.ab_w_in = (const float*)d_in[2]; p.ab_conv_w = (const float*)d_in[3]; p.ab_conv_b = (const float*)d_in[4];
  p.ga_w = (const float*)d_in[5]; p.ga_b = (const float*)d_in[6]; p.gx_w = (const float*)d_in[7]; p.gx_b = (const float*)d_in[8];
  p.lam = (const float*)d_in[9]; p.qn = (const float*)d_in[10]; p.kvn = (const float*)d_in[11]; p.w_uq = (const float*)d_in[12];
  p.w_ukv = (const float*)d_in[13]; p.ab_w_out = (const float*)d_in[14]; p.ab_ln_g = (const float*)d_in[15]; p.ab_ln_b = (const float*)d_in[16];
  p.ssd_w_in = (const float*)d_in[17]; p.ssd_conv_w = (const float*)d_in[18]; p.ssd_conv_b = (const float*)d_in[19]; p.dt_bias = (const float*)d_in[20];
  p.a_log = (const float*)d_in[21]; p.ssd_d = (const float*)d_in[22]; p.ssd_norm = (const float*)d_in[23]; p.ssd_w_out = (const float*)d_in[24];
  p.ssd_ln_g = (const float*)d_in[25]; p.ssd_ln_b = (const float*)d_in[26];
  p.out = (float*)d_out; p.ws = (char*)d_ws;
  void* args[] = {&p};
  hipError_t e = hipLaunchCooperativeKernel((void*)fwd_megakernel, dim3(grid_blocks), dim3(NT), args, 0, stream);
  if (e != hipSuccess) fprintf(stderr, "cooperative launch failed: %s (grid %d)\n", hipGetErrorString(e), grid_blocks);
}
```

```cpp
#include <hip/hip_runtime.h>
#include <hip/hip_cooperative_groups.h>
#include <cstdio>
namespace cg = cooperative_groups;

typedef unsigned short u16;
typedef short bf16x8 __attribute__((ext_vector_type(8)));
typedef short s16x4 __attribute__((ext_vector_type(4)));
typedef float f32x16 __attribute__((ext_vector_type(16)));
typedef float f32x4 __attribute__((ext_vector_type(4)));
typedef unsigned u32x4 __attribute__((ext_vector_type(4)));
typedef unsigned u32x2 __attribute__((ext_vector_type(2)));
typedef __bf16 bf2_t __attribute__((ext_vector_type(2)));

#define DI __device__ __forceinline__
#define NT 512
__device__ __forceinline__ int tid_() { int t = threadIdx.x; asm volatile("" : "+v"(t)); return t; }
#define MFMA32(a, b, c) __builtin_amdgcn_mfma_f32_32x32x16_bf16((a), (b), (c), 0, 0, 0)

constexpr int T = 32768, SEQ = 4096;
constexpr float DN_ALPHA = 1.41421356237309515f;
constexpr size_t Mi = 1024ull * 1024ull;
constexpr size_t OFF_W1T = 0, OFF_WOT = 4 * Mi, OFF_W2T = 6 * Mi, OFF_W3T = 16 * Mi + 512 * 1024, OFF_WQT = 20 * Mi + 512 * 1024,
                 OFF_WKVT = 21 * Mi, OFF_WAT = 21 * Mi + 256 * 1024, OFF_WXT = 21 * Mi + 320 * 1024, OFF_COS = 21 * Mi + 512 * 1024,
                 OFF_SIN = 23 * Mi + 512 * 1024, OFF_HEND = 25 * Mi + 512 * 1024, OFF_PEND = 26 * Mi, OFF_SS = 26 * Mi + 512 * 1024,
                 OFF_DT = 27 * Mi, OFF_XB = 32 * Mi, OFF_YCAT = 32 * Mi, OFF_X1B = 32 * Mi, OFF_BC = 32 * Mi, OFF_PROJ0 = 96 * Mi,
                 OFF_HLOC = 224 * Mi, OFF_PCUM = 256 * Mi, OFF_Q = 288 * Mi, OFF_KC = 336 * Mi, OFF_VT = 384 * Mi, OFF_PROJ1 = 96 * Mi,
                 OFF_Z = 96 * Mi, OFF_XBC = 224 * Mi, OFF_HALO = 416 * Mi, OFF_CS = 428 * Mi, OFF_SP = 31 * Mi;
constexpr int LD0 = 2048, LD1 = 5376;

struct Params {
  const float* x; const int* pos;
  const float *ab_w_in, *ab_conv_w, *ab_conv_b, *ga_w, *ga_b, *gx_w, *gx_b, *lam, *qn, *kvn, *w_uq, *w_ukv, *ab_w_out, *ab_ln_g, *ab_ln_b;
  const float *ssd_w_in, *ssd_conv_w, *ssd_conv_b, *dt_bias, *a_log, *ssd_d, *ssd_norm, *ssd_w_out, *ssd_ln_g, *ssd_ln_b;
  float* out; char* ws;
};

DI unsigned pk2(float a, float b) { bf2_t v; v[0] = (__bf16)a; v[1] = (__bf16)b; return __builtin_bit_cast(unsigned, v); }
DI u16 f2bf(float a) { __bf16 v = (__bf16)a; return __builtin_bit_cast(u16, v); }
DI float bflo(unsigned w) { return __uint_as_float(w << 16); }
DI float bfhi(unsigned w) { return __uint_as_float(w & 0xffff0000u); }
DI float bf2f(u16 v) { return __uint_as_float(((unsigned)v) << 16); }
DI float fast_exp2(float x) { return __builtin_amdgcn_exp2f(x); }
DI float fast_exp(float x) { return __builtin_amdgcn_exp2f(x * 1.44269504088896341f); }
DI float fast_rcp(float x) { return __builtin_amdgcn_rcpf(x); }
DI float sigmoidf_(float x) { return fast_rcp(1.0f + fast_exp(-x)); }
DI float siluf_(float x) { return x * sigmoidf_(x); }
DI int crow(int i, int h) { return (i & 3) + 8 * (i >> 2) + 4 * h; }
DI void unpack8(const u32x4& v, float* f) {
  f[0] = bflo(v.x); f[1] = bfhi(v.x); f[2] = bflo(v.y); f[3] = bfhi(v.y); f[4] = bflo(v.z); f[5] = bfhi(v.z); f[6] = bflo(v.w); f[7] = bfhi(v.w);
}
DI u32x4 pack8(const float* f) { u32x4 v; v.x = pk2(f[0], f[1]); v.y = pk2(f[2], f[3]); v.z = pk2(f[4], f[5]); v.w = pk2(f[6], f[7]); return v; }
DI bf16x8 pack_frag(const f32x16& x, int s) {
  u32x4 v; v.x = pk2(x[8 * s], x[8 * s + 1]); v.y = pk2(x[8 * s + 2], x[8 * s + 3]); v.z = pk2(x[8 * s + 4], x[8 * s + 5]); v.w = pk2(x[8 * s + 6], x[8 * s + 7]);
  return __builtin_bit_cast(bf16x8, v);
}
DI bf16x8 ld_frag16(const u16* p) { return *(const bf16x8*)p; }
DI bf16x8 ld_frag8x2(const u16* p0, const u16* p1) {
  s16x4 lo = *(const s16x4*)p0, hi = *(const s16x4*)p1;
  return __builtin_shufflevector(lo, hi, 0, 1, 2, 3, 4, 5, 6, 7);
}

DI void tr_tile(const float* __restrict__ src, u16* __restrict__ dst, int K, int N, const float* __restrict__ scale, int kt, int nt, char* smem) {
  float* tf = (float*)smem;
  const int tid = tid_(), k0 = kt * 64, n0 = nt * 64;
#pragma unroll
  for (int i = 0; i < 8; ++i) {
    const int kk = (tid >> 6) + 8 * i, nn = tid & 63;
    float v = 0.f;
    if (n0 + nn < N) { v = src[(size_t)(k0 + kk) * N + n0 + nn]; if (scale) v *= scale[k0 + kk]; }
    tf[kk * 65 + nn] = v;
  }
  __syncthreads();
#pragma unroll
  for (int i = 0; i < 8; ++i) {
    const int nn = (tid >> 6) + 8 * i, kk = tid & 63;
    dst[(size_t)(n0 + nn) * K + k0 + kk] = f2bf(tf[kk * 65 + nn]);
  }
  __syncthreads();
}
DI void tr_job(const float* src, u16* dst, int K, int N, int Npad, const float* scale, int& rot, char* smem) {
  const int nkt = K / 64, nnt = Npad / 64, n = nkt * nnt, nb = gridDim.x;
  for (int it = (blockIdx.x + nb - rot) % nb; it < n; it += nb) tr_tile(src, dst, K, N, scale, it % nkt, it / nkt, smem);
  rot = (rot + n) % nb;
}

DI void phase_prep(const Params& p, char* smem) {
  char* ws = p.ws;
  int rot = 0;
  tr_job(p.ab_w_in, (u16*)(ws + OFF_W1T), 1024, 1952, 2048, nullptr, rot, smem);
  tr_job(p.ssd_w_in, (u16*)(ws + OFF_W2T), 1024, 5152, 5376, nullptr, rot, smem);
  tr_job(p.ab_w_out, (u16*)(ws + OFF_WOT), 1024, 1024, 1024, nullptr, rot, smem);
  tr_job(p.ssd_w_out, (u16*)(ws + OFF_W3T), 2048, 1024, 1024, p.ssd_norm, rot, smem);
  tr_job(p.w_uq, (u16*)(ws + OFF_WQT), 256, 768, 768, p.qn, rot, smem);
  tr_job(p.w_ukv, (u16*)(ws + OFF_WKVT), 128, 1024, 1024, p.kvn, rot, smem);
  for (int hd = 0; hd < 8; ++hd) {
    tr_job(p.ga_w + hd * 4096, (u16*)(ws + OFF_WAT) + hd * 4096, 64, 64, 64, nullptr, rot, smem);
    tr_job(p.gx_w + hd * 4096, (u16*)(ws + OFF_WXT) + hd * 4096, 64, 64, 64, nullptr, rot, smem);
  }
  const size_t gid = (size_t)blockIdx.x * NT + tid_(), gstride = (size_t)gridDim.x * NT;
  {
    const f32x4* xs = (const f32x4*)p.x; u32x4* xb = (u32x4*)(ws + OFF_XB);
    const size_t n8 = (size_t)T * 1024 / 8;
    for (size_t i = gid; i < n8; i += gstride) {
      const f32x4 a = xs[2 * i], b = xs[2 * i + 1];
      u32x4 o; o.x = pk2(a.x, a.y); o.y = pk2(a.z, a.w); o.z = pk2(b.x, b.y); o.w = pk2(b.z, b.w);
      xb[i] = o;
    }
  }
  {
    float* ct = (float*)(ws + OFF_COS); float* st = (float*)(ws + OFF_SIN);
    for (size_t i = gid; i < (size_t)T * 16; i += gstride) {
      const int t = (int)(i >> 4), j = (int)(i & 15);
      const float inv = exp2f(-(float)j * (13.287712379549449f / 16.0f));
      const float ang = (float)p.pos[t] * inv;
      const double rev = (double)ang * 0.15915494309189535;
      const double fr = rev - rint(rev);
      const float a = (float)(fr * 6.283185307179586);
      ct[i] = cosf(a); st[i] = sinf(a);
    }
  }
  { float* sp = (float*)(ws + OFF_SP); for (size_t i = gid; i < 512; i += gstride) sp[i] = log1pf(expf(-p.lam[i])); }
  {
    float* ss = (float*)(ws + OFF_SS);
    for (size_t i = gid; i < (size_t)T * 4; i += gstride) ss[i] = 0.f;
  }
}

constexpr int GA_ST = 72;
constexpr float QSCALE = 0.10206207261596575f * 1.44269504088896341f;

template <int MODE>
DI void gemm_epi(const Params& p, int row, int colbase, int h, const f32x16& v, float rs) {
  char* ws = p.ws;
  if constexpr (MODE == 1) {
    u16* dst = (u16*)(ws + OFF_PROJ0) + (size_t)row * LD0;
#pragma unroll
    for (int g = 0; g < 4; ++g) {
      const int col = colbase + 8 * g + 4 * h;
      float a = v[4 * g], b = v[4 * g + 1], c = v[4 * g + 2], d = v[4 * g + 3];
      if (col >= 512 && col < 1536) { a = siluf_(a); b = siluf_(b); c = siluf_(c); d = siluf_(d); }
      u32x2 o; o.x = pk2(a, b); o.y = pk2(c, d);
      *(u32x2*)(dst + col) = o;
    }
  } else if constexpr (MODE == 2) {
    u16* dst = (u16*)(ws + OFF_Q) + (size_t)row * 768;
    f32x16 o;
    if ((colbase % 96) == 64) {
      const float* ct = (const float*)(ws + OFF_COS) + (size_t)row * 16;
      const float* st = (const float*)(ws + OFF_SIN) + (size_t)row * 16;
#pragma unroll
      for (int i = 0; i < 8; ++i) {
        const int idx = crow(i, h);
        const float c = ct[idx], s = st[idx], x1 = v[i] * rs, x2 = v[i + 8] * rs;
        o[i] = (x1 * c - x2 * s) * QSCALE; o[i + 8] = (x2 * c + x1 * s) * QSCALE;
      }
    } else {
#pragma unroll
      for (int i = 0; i < 16; ++i) o[i] = v[i] * (rs * QSCALE);
    }
#pragma unroll
    for (int g = 0; g < 4; ++g) {
      u32x2 w; w.x = pk2(o[4 * g], o[4 * g + 1]); w.y = pk2(o[4 * g + 2], o[4 * g + 3]);
      *(u32x2*)(dst + colbase + 8 * g + 4 * h) = w;
    }
  } else if constexpr (MODE == 3) {
    const int hd = colbase >> 7, within = colbase & 127;
    if (within < 64) {
      u16* dst = (u16*)(ws + OFF_KC) + (size_t)row * 768 + hd * 96 + within;
#pragma unroll
      for (int g = 0; g < 4; ++g) {
        u32x2 w; w.x = pk2(v[4 * g] * rs, v[4 * g + 1] * rs); w.y = pk2(v[4 * g + 2] * rs, v[4 * g + 3] * rs);
        *(u32x2*)(dst + 8 * g + 4 * h) = w;
      }
    } else {
      const int b = row >> 12, s = row & 4095;
      u16* dst = (u16*)(ws + OFF_VT) + ((size_t)(b * 8 + hd) * 64 + (within - 64)) * SEQ + s;
#pragma unroll
      for (int i = 0; i < 16; ++i) dst[(size_t)crow(i, h) * SEQ] = f2bf(v[i] * rs);
    }
  } else if constexpr (MODE == 4 || MODE == 6) {
    const float* src = (MODE == 4) ? p.x : p.out;
#pragma unroll
    for (int g = 0; g < 4; ++g) {
      const size_t off = (size_t)row * 1024 + colbase + 8 * g + 4 * h;
      const f32x4 xv = *(const f32x4*)(src + off);
      f32x4 o; o.x = DN_ALPHA * xv.x + v[4 * g]; o.y = DN_ALPHA * xv.y + v[4 * g + 1]; o.z = DN_ALPHA * xv.z + v[4 * g + 2]; o.w = DN_ALPHA * xv.w + v[4 * g + 3];
      *(f32x4*)(p.out + off) = o;
    }
  } else if constexpr (MODE == 5) {
    if (colbase < 5120) {
      u16* dst = (u16*)(ws + OFF_PROJ1) + (size_t)row * LD1;
#pragma unroll
      for (int g = 0; g < 4; ++g) {
        const int col = colbase + 8 * g + 4 * h;
        float a = v[4 * g], b = v[4 * g + 1], c = v[4 * g + 2], d = v[4 * g + 3];
        if (col < 2048) { a = siluf_(a); b = siluf_(b); c = siluf_(c); d = siluf_(d); }
        u32x2 o; o.x = pk2(a, b); o.y = pk2(c, d);
        *(u32x2*)(dst + col) = o;
      }
    } else if (colbase == 5120) {
      float* dst = (float*)(ws + OFF_DT) + (size_t)row * 32;
#pragma unroll
      for (int i = 0; i < 16; ++i) {
        const int c = crow(i, h);
        const float xv = v[i] + p.dt_bias[c];
        dst[c] = fmaxf(xv, 0.f) + log1pf(expf(-fabsf(xv)));
      }
    }
  }
}

template <int MODE>
DI void gemm_tile(const Params& p, const u16* __restrict__ A, int lda, const u16* __restrict__ Bt, int K, int m0, int n0, char* smem) {
  constexpr bool ROWNORM = (MODE == 2 || MODE == 3);
  constexpr bool GROUPS = (MODE == 6);
  u16* As = (u16*)smem;
  u16* Bs = (u16*)(smem + 2 * 256 * GA_ST * 2);
  float* ssrow = (float*)(smem + 2 * 256 * GA_ST * 2 + 2 * 128 * GA_ST * 2);
  const int tid = tid_(), lane = tid & 63, w = tid >> 6, wm = w & 3, wn = w >> 2, r = lane & 31, h = lane >> 5;
  const int lrow = tid >> 3, lkc = (tid & 7) * 8;
  const u16* ag = A + (size_t)(m0 + lrow) * lda + lkc;
  const u16* bg = Bt + (size_t)(n0 + lrow) * K + lkc;
  u32x4 ra[4], rb[2];
  float ssq[4] = {0.f, 0.f, 0.f, 0.f};
  f32x16 acc[2][2];
#pragma unroll
  for (int i = 0; i < 2; ++i)
#pragma unroll
    for (int j = 0; j < 2; ++j)
#pragma unroll
      for (int e = 0; e < 16; ++e) acc[i][j][e] = 0.f;
  const int nk = K / 64;
  auto gload = [&](int kt) {
#pragma unroll
    for (int i = 0; i < 4; ++i) ra[i] = *(const u32x4*)(ag + (size_t)(64 * i) * lda + kt * 64);
#pragma unroll
    for (int i = 0; i < 2; ++i) rb[i] = *(const u32x4*)(bg + (size_t)(64 * i) * K + kt * 64);
  };
  auto lstore = [&](int buf) {
    u16* as = As + buf * 256 * GA_ST; u16* bs = Bs + buf * 128 * GA_ST;
#pragma unroll
    for (int i = 0; i < 4; ++i) {
      *(u32x4*)(as + (lrow + 64 * i) * GA_ST + lkc) = ra[i];
      if constexpr (ROWNORM) { float f[8]; unpack8(ra[i], f);
#pragma unroll
        for (int e = 0; e < 8; ++e) ssq[i] += f[e] * f[e]; }
    }
#pragma unroll
    for (int i = 0; i < 2; ++i) *(u32x4*)(bs + (lrow + 64 * i) * GA_ST + lkc) = rb[i];
  };
  gload(0); lstore(0);
  __syncthreads();
  for (int kt = 0; kt < nk; ++kt) {
    const int buf = kt & 1;
    if (kt + 1 < nk) gload(kt + 1);
    const u16* as = As + buf * 256 * GA_ST + (wm * 64 + r) * GA_ST + h * 8;
    const u16* bs = Bs + buf * 128 * GA_ST + (wn * 64 + r) * GA_ST + h * 8;
#pragma unroll
    for (int ks = 0; ks < 4; ++ks) {
      const bf16x8 a0 = ld_frag16(as + ks * 16), a1 = ld_frag16(as + 32 * GA_ST + ks * 16);
      const bf16x8 b0 = ld_frag16(bs + ks * 16), b1 = ld_frag16(bs + 32 * GA_ST + ks * 16);
      acc[0][0] = MFMA32(b0, a0, acc[0][0]); acc[0][1] = MFMA32(b1, a0, acc[0][1]);
      acc[1][0] = MFMA32(b0, a1, acc[1][0]); acc[1][1] = MFMA32(b1, a1, acc[1][1]);
    }
    if constexpr (GROUPS) {
      if ((kt & 7) == 7) {
        const int g = kt >> 3;
        const float* ss = (const float*)(p.ws + OFF_SS);
#pragma unroll
        for (int mi = 0; mi < 2; ++mi) {
          const int row = m0 + wm * 64 + mi * 32 + r;
          const float sg = rsqrtf(ss[(size_t)row * 4 + g] * (1.0f / 512.0f) + 1e-6f);
          float sc = sg;
          if (g < 3) sc = sg * sqrtf(ss[(size_t)row * 4 + g + 1] * (1.0f / 512.0f) + 1e-6f);
#pragma unroll
          for (int ni = 0; ni < 2; ++ni)
#pragma unroll
            for (int e = 0; e < 16; ++e) acc[mi][ni][e] *= sc;
        }
      }
    }
    if (kt + 1 < nk) lstore(buf ^ 1);
    __syncthreads();
  }
  float rsv[2] = {1.f, 1.f};
  if constexpr (ROWNORM) {
#pragma unroll
    for (int i = 0; i < 4; ++i) {
      float s = ssq[i];
      s += __shfl_xor(s, 1); s += __shfl_xor(s, 2); s += __shfl_xor(s, 4);
      if ((tid & 7) == 0) ssrow[lrow + 64 * i] = s;
    }
    __syncthreads();
#pragma unroll
    for (int mi = 0; mi < 2; ++mi) rsv[mi] = rsqrtf(ssrow[wm * 64 + mi * 32 + r] / (float)K + 1e-6f);
  }
#pragma unroll
  for (int mi = 0; mi < 2; ++mi)
#pragma unroll
    for (int ni = 0; ni < 2; ++ni) {
      const int row = m0 + wm * 64 + mi * 32 + r, colbase = n0 + wn * 64 + ni * 32;
      gemm_epi<MODE>(p, row, colbase, h, acc[mi][ni], rsv[mi]);
    }
  __syncthreads();
}

template <int MODE>
DI void gemm_phase(const Params& p, const u16* A, int lda, const u16* Bt, int K, int Npad, int& rot, char* smem) {
  const int nN = Npad / 128, n = (T / 256) * nN, nb = gridDim.x;
  for (int it = (blockIdx.x + nb - rot) % nb; it < n; it += nb) gemm_tile<MODE>(p, A, lda, Bt, K, (it / nN) * 256, (it % nN) * 128, smem);
  rot = (rot + n) % nb;
}

namespace pg8 {
#define PG8_LAS __attribute__((address_space(3)))
typedef unsigned short bf16_t;
typedef short bf16x8 __attribute__((ext_vector_type(8)));
typedef float f32x4 __attribute__((ext_vector_type(4)));
typedef unsigned u32x4 __attribute__((ext_vector_type(4)));
constexpr int BM = 256, BK = 64, HALF = 128, HTB = HALF * BK * 2  , STAGE_BYTES = 8 * HTB, NXCD = 8, WGM = 8;

__host__ __device__ __forceinline__ int lds_byte(int r, int c) { const int st = (r >> 4) * 2 + (c >> 5), rr = r & 15, cc = c & 31, ob = rr * 64 + cc * 2; return st * 1024 + (ob ^ (((ob >> 9) & 1) << 5)); }
__host__ __device__ __forceinline__ void stage_rc(int b, int& R, int& C) { const int st = b / 1024, sb = b % 1024, swz = sb ^ (((sb >> 9) & 1) << 5); R = (st >> 1) * 16 + swz / 64; C = (st & 1) * 32 + (swz % 64) / 2; }
__host__ __device__ __forceinline__ int perm32(int rho) { const int n = rho >> 4, i = rho & 15; return 8 * (i >> 2) + 4 * n + (i & 3); }

struct Unit { int pm, pn; };
struct Gemm { const bf16_t* A; const bf16_t* Bt; int M, N, K, lda; };

struct StaticOrder {
    int nM, nN, nwg, G, c;
    __host__ __device__ void init(int M, int N, int G_, int c_) { nM = M / BM; nN = N / BM; nwg = nM * nN; G = G_; c = c_; }
    __host__ __device__ bool next(int i, Unit& u) const {
        const long L = (long)i * G + c; if (L >= nwg) return false;
        int wgid = (int)L; { const int q = nwg / NXCD, r = nwg % NXCD, xcd = wgid % NXCD, off = wgid / NXCD; wgid = (xcd < r ? xcd * (q + 1) : r * (q + 1) + (xcd - r) * q) + off; }
        const int nig = WGM * nN, gid = wgid / nig, fm = gid * WGM, gsz = (nM - fm) < WGM ? (nM - fm) : WGM;
        u.pm = fm + ((wgid % nig) % gsz); u.pn = (wgid % nig) / gsz; return true;
    }
    __device__ __forceinline__ void a_ready(const Unit&) const {}
    __device__ __forceinline__ void done(const Unit&) const {}
};
template <class Epi, class Sched, bool STAMP = false>
__device__ __forceinline__ void gemm_phase(PG8_LAS unsigned char* lds, const Gemm g, const Sched& S, const Epi& E, unsigned long long* stamps) {
    const int tid = tid_(), wid = __builtin_amdgcn_readfirstlane(tid >> 6), lane = tid & 63, wr = wid >> 2, wc = wid & 3, fr = lane & 15, fq = lane >> 4;
    const int K = g.K, nt = K / BK;
    int ts_lo = 0, ts_hi = 0, nts = 0; const unsigned long long rt_entry = STAMP ? (unsigned long long)wall_clock64() : 0ull;
#define PG8_STAMP() do { if (STAMP && wid == 0 && nts < 64) { const unsigned long long _c = (unsigned long long)clock64(); \
        ts_lo = (lane == nts) ? (int)(unsigned)_c : ts_lo; ts_hi = (lane == nts) ? (int)(unsigned)(_c >> 32) : ts_hi; ++nts; } } while (0)
    PG8_STAMP();
    unsigned voffA[2], voffB[2];
#pragma unroll
    for (int i = 0; i < 2; ++i) { int R, C; stage_rc(tid * 16 + i * 8192, R, C); const int Rb = Epi::PERM ? ((R & ~31) + perm32(R & 31)) : R;
        voffA[i] = (unsigned)(R * g.lda + C) * 2u; voffB[i] = (unsigned)(Rb * K + C) * 2u; }
    const size_t kstep = (size_t)(BK * 2);
    const size_t hstepA = (size_t)HALF * g.lda * 2, hstepB = (size_t)HALF * K * 2;
    const size_t tstepA = 2 * hstepA, tstepB = 2 * hstepB;
    const unsigned ldsw = (unsigned)wid * 1024u;
    const int aoff = lds_byte(wr * 64 + fr, fq * 8), boff = lds_byte(wc * 32 + fr, fq * 8);
#define PG8_SA(b, h) (((b) * 2 + (h)) * HTB)
#define PG8_SB(b, h) ((4 + (b) * 2 + (h)) * HTB)
#define PG8_STAGE(bufoff, gbase, voff) do { _Pragma("unroll") for (int _i = 0; _i < 2; ++_i) \
        __builtin_amdgcn_global_load_lds((const unsigned*)((const char*)(gbase) + (voff)[_i]), (PG8_LAS unsigned*)(lds + (bufoff) + ldsw + _i * 8192), 16, 0, 0); } while (0)
#define PG8_LDA(dst, b, h) do { _Pragma("unroll") for (int m = 0; m < 4; ++m) _Pragma("unroll") for (int k = 0; k < 2; ++k) dst[m][k] = *(const PG8_LAS bf16x8*)(lds + PG8_SA(b, h) + aoff + m * 2048 + k * 1024); } while (0)
#define PG8_LDB(dst, b, h) do { _Pragma("unroll") for (int n = 0; n < 2; ++n) _Pragma("unroll") for (int k = 0; k < 2; ++k) dst[n][k] = *(const PG8_LAS bf16x8*)(lds + PG8_SB(b, h) + boff + n * 2048 + k * 1024); } while (0)
#define PG8_MMA(ai, bj, At, Bt) do { __builtin_amdgcn_s_setprio(1); _Pragma("unroll") for (int m = 0; m < 4; ++m) _Pragma("unroll") for (int n = 0; n < 2; ++n) _Pragma("unroll") for (int k = 0; k < 2; ++k) \
        acc[ai][bj][m][n] = __builtin_amdgcn_mfma_f32_16x16x32_bf16(Bt[n][k], At[m][k], acc[ai][bj][m][n], 0, 0, 0); __builtin_amdgcn_s_setprio(0); } while (0)
#define PG8_WAIT_V(n) asm volatile("s_waitcnt vmcnt(" #n ")" ::: "memory")
#define PG8_WAIT_L(n) asm volatile("s_waitcnt lgkmcnt(" #n ")" ::: "memory")
#define PG8_BAR __builtin_amdgcn_s_barrier()
#define PG8_SCHED __builtin_amdgcn_sched_barrier(0)
    Unit cur, nxt; int ui = 0;
    if (!S.next(0, cur)) return;
    f32x4 acc[2][2][4][2];
#pragma unroll
    for (int a = 0; a < 2; ++a)
#pragma unroll
        for (int b = 0; b < 2; ++b)
#pragma unroll
            for (int m = 0; m < 4; ++m)
#pragma unroll
                for (int n = 0; n < 2; ++n) acc[a][b][m][n] = (f32x4){0.f, 0.f, 0.f, 0.f};
    bf16x8 At[4][2], B0[2][2], B1[2][2];
    const char* cA = (const char*)g.A + (size_t)cur.pm * tstepA; const char* cB = (const char*)g.Bt + (size_t)cur.pn * tstepB;
    S.a_ready(cur);
    PG8_STAGE(PG8_SB(0, 0), cB, voffB); PG8_STAGE(PG8_SA(0, 0), cA, voffA); PG8_STAGE(PG8_SB(0, 1), cB + hstepB, voffB); PG8_STAGE(PG8_SA(0, 1), cA + hstepA, voffA);
    if (wr == 1) PG8_BAR;
    PG8_WAIT_V(4); PG8_BAR;
    PG8_STAGE(PG8_SB(1, 0), cB + kstep, voffB); PG8_STAGE(PG8_SA(1, 0), cA + kstep, voffA); PG8_STAGE(PG8_SB(1, 1), cB + hstepB + kstep, voffB);
    PG8_WAIT_V(6); PG8_BAR;
    PG8_STAMP();
    for (;;) {
        const bool has_next = S.next(ui + 1, nxt);
        const char* nA = has_next ? (const char*)g.A + (size_t)nxt.pm * tstepA : cA; const char* nB = has_next ? (const char*)g.Bt + (size_t)nxt.pn * tstepB : cB;
        for (int t = 0; t < nt; t += 2) {
            const bool last = (t == nt - 2);
            const char* a1 = cA + (size_t)(t + 1) * kstep;
            const char* a2 = last ? nA : cA + (size_t)(t + 2) * kstep; const char* b2 = last ? nB : cB + (size_t)(t + 2) * kstep;
            const char* a3 = a2 + kstep; const char* b3 = b2 + kstep;
            if (last && has_next) S.a_ready(nxt);
            PG8_LDB(B0, 0, 0); PG8_SCHED; PG8_LDA(At, 0, 0); PG8_STAGE(PG8_SA(1, 1), a1 + hstepA, voffA);
            PG8_WAIT_L(8); PG8_BAR; PG8_WAIT_L(0); PG8_MMA(0, 0, At, B0); PG8_BAR; PG8_SCHED;
            PG8_LDB(B1, 0, 1); PG8_STAGE(PG8_SB(0, 0), b2, voffB);
            PG8_BAR; PG8_WAIT_L(0); PG8_MMA(0, 1, At, B1); PG8_BAR;
            PG8_LDA(At, 0, 1); PG8_STAGE(PG8_SA(0, 0), a2, voffA);
            PG8_BAR; PG8_WAIT_L(0); PG8_MMA(1, 0, At, B0); PG8_BAR; PG8_SCHED;
            PG8_STAGE(PG8_SB(0, 1), b2 + hstepB, voffB);
            PG8_WAIT_V(6); PG8_BAR; PG8_MMA(1, 1, At, B1); PG8_BAR;
            PG8_LDB(B0, 1, 0); PG8_SCHED; PG8_LDA(At, 1, 0); PG8_STAGE(PG8_SA(0, 1), a2 + hstepA, voffA);
            PG8_WAIT_L(8); PG8_BAR; PG8_WAIT_L(0); PG8_MMA(0, 0, At, B0); PG8_BAR; PG8_SCHED;
            PG8_LDB(B1, 1, 1); PG8_STAGE(PG8_SB(1, 0), b3, voffB);
            PG8_BAR; PG8_WAIT_L(0); PG8_MMA(0, 1, At, B1); PG8_BAR;
            PG8_LDA(At, 1, 1); PG8_STAGE(PG8_SA(1, 0), a3, voffA);
            PG8_BAR; PG8_WAIT_L(0); PG8_MMA(1, 0, At, B0); PG8_BAR; PG8_SCHED;
            PG8_STAGE(PG8_SB(1, 1), b3 + hstepB, voffB);
            PG8_WAIT_V(6); PG8_BAR; PG8_MMA(1, 1, At, B1); PG8_BAR;
            if constexpr (Epi::KHOOK) { if (((t + 2) & 7) == 0) E.khook(acc, cur, ((t + 2) >> 3) - 1, wr, wc, fr, fq); }
        }
        PG8_STAMP();
        if constexpr (!Epi::AFTER_DRAIN) { E(acc, cur, wr, wc, fr, fq); S.done(cur); }
        PG8_STAMP();
        if (!has_next) break;
#pragma unroll
        for (int a = 0; a < 2; ++a)
#pragma unroll
            for (int b = 0; b < 2; ++b)
#pragma unroll
                for (int m = 0; m < 4; ++m)
#pragma unroll
                    for (int n = 0; n < 2; ++n) acc[a][b][m][n] = (f32x4){0.f, 0.f, 0.f, 0.f};
        cur = nxt; cA = nA; cB = nB; ++ui;
    }
    PG8_WAIT_V(0);
    if (wr == 0) PG8_BAR;
    PG8_BAR;
    if constexpr (Epi::AFTER_DRAIN) { E.fused(acc, cur, wr, wc, fr, fq, lds, wid, lane); S.done(cur); }
    PG8_STAMP();
    if (STAMP && wid == 0) { stamps[lane] = lane < nts ? (((unsigned long long)(unsigned)ts_hi << 32) | (unsigned)ts_lo) : 0ull;
        if (lane == 62) stamps[62] = rt_entry; if (lane == 63) stamps[63] = (unsigned long long)wall_clock64(); }
#undef PG8_STAMP
#undef PG8_SA
#undef PG8_SB
#undef PG8_STAGE
#undef PG8_LDA
#undef PG8_LDB
#undef PG8_MMA
#undef PG8_WAIT_V
#undef PG8_WAIT_L
#undef PG8_BAR
#undef PG8_SCHED
}
}

struct EpiProj0 {
  static constexpr bool PERM = true, AFTER_DRAIN = false, KHOOK = false;
  u16* O;
  DI void operator()(const f32x4 (&acc)[2][2][4][2], const pg8::Unit& u, int wr, int wc, int fr, int fq) const {
    const int row0 = u.pm * 256 + wr * 64 + fr;
#pragma unroll
    for (int ai = 0; ai < 2; ++ai)
#pragma unroll
      for (int m = 0; m < 4; ++m) {
        u16* rowp = O + (size_t)(row0 + ai * 128 + m * 16) * LD0;
#pragma unroll
        for (int bj = 0; bj < 2; ++bj) {
          const int colb = u.pn * 256 + bj * 128;
          f32x4 v0 = acc[ai][bj][m][0], v1 = acc[ai][bj][m][1];
          if (colb >= 512 && colb < 1536) {
#pragma unroll
            for (int e = 0; e < 4; ++e) { v0[e] = siluf_(v0[e]); v1[e] = siluf_(v1[e]); }
          }
          u32x4 w; w.x = pk2(v0[0], v0[1]); w.y = pk2(v0[2], v0[3]); w.z = pk2(v1[0], v1[1]); w.w = pk2(v1[2], v1[3]);
          *(u32x4*)(rowp + colb + wc * 32 + 8 * fq) = w;
        }
      }
  }
};
struct EpiProj1 {
  static constexpr bool PERM = true, AFTER_DRAIN = false, KHOOK = false;
  u16* Z; u16* X; u16* H; float* dt;
  DI void operator()(const f32x4 (&acc)[2][2][4][2], const pg8::Unit& u, int wr, int wc, int fr, int fq) const {
    const int row0 = u.pm * 256 + wr * 64 + fr;
#pragma unroll
    for (int ai = 0; ai < 2; ++ai)
#pragma unroll
      for (int m = 0; m < 4; ++m) {
        const int row = row0 + ai * 128 + m * 16;
#pragma unroll
        for (int bj = 0; bj < 2; ++bj) {
          const int colb = u.pn * 256 + bj * 128, col = colb + wc * 32 + 8 * fq;
          f32x4 v0 = acc[ai][bj][m][0], v1 = acc[ai][bj][m][1];
          if (colb < 2048) {
#pragma unroll
            for (int e = 0; e < 4; ++e) { v0[e] = siluf_(v0[e]); v1[e] = siluf_(v1[e]); }
            u32x4 w; w.x = pk2(v0[0], v0[1]); w.y = pk2(v0[2], v0[3]); w.z = pk2(v1[0], v1[1]); w.w = pk2(v1[2], v1[3]);
            *(u32x4*)(Z + (size_t)row * 2048 + col) = w;
          } else if (colb < 5120) {
            u32x4 w; w.x = pk2(v0[0], v0[1]); w.y = pk2(v0[2], v0[3]); w.z = pk2(v1[0], v1[1]); w.w = pk2(v1[2], v1[3]);
            *(u32x4*)(X + (size_t)row * 3072 + (col - 2048)) = w;
            if ((row & 63) >= 61) *(u32x4*)(H + ((size_t)(row >> 6) * 3 + ((row & 63) - 61)) * 3072 + (col - 2048)) = w;
          } else if (colb == 5120 && wc == 0) {
            *(f32x4*)(dt + (size_t)row * 32 + 8 * fq) = v0; *(f32x4*)(dt + (size_t)row * 32 + 8 * fq + 4) = v1;
          }
        }
      }
  }
};
template <bool HOOK> struct EpiResid {
  static constexpr bool PERM = false, AFTER_DRAIN = false, KHOOK = HOOK;
  const float* src; float* dst; const float* ss;
  DI void khook(f32x4 (&acc)[2][2][4][2], const pg8::Unit& u, int g, int wr, int wc, int fr, int fq) const {
    const int row0 = u.pm * 256 + wr * 64 + fr;
    float sc[2][4];
#pragma unroll
    for (int ai = 0; ai < 2; ++ai)
#pragma unroll
      for (int m = 0; m < 4; ++m) {
        const float* sp = ss + (size_t)(row0 + ai * 128 + m * 16) * 4;
        const float a = sp[g], b = sp[(g < 3) ? g + 1 : g];
        float s = rsqrtf(a * (1.0f / 512.0f) + 1e-6f);
        if (g < 3) s *= sqrtf(b * (1.0f / 512.0f) + 1e-6f);
        sc[ai][m] = s;
      }
    asm volatile("s_waitcnt vmcnt(0)" ::: "memory");
#pragma unroll
    for (int ai = 0; ai < 2; ++ai)
#pragma unroll
      for (int m = 0; m < 4; ++m)
#pragma unroll
        for (int bj = 0; bj < 2; ++bj)
#pragma unroll
          for (int n = 0; n < 2; ++n) acc[ai][bj][m][n] *= sc[ai][m];
  }
  DI void operator()(const f32x4 (&acc)[2][2][4][2], const pg8::Unit& u, int wr, int wc, int fr, int fq) const {
    const int row0 = u.pm * 256 + wr * 64 + fr, col0 = u.pn * 256 + wc * 32 + 4 * fq;
#pragma unroll
    for (int ai = 0; ai < 2; ++ai)
#pragma unroll
      for (int m = 0; m < 4; ++m) {
        const size_t ro = (size_t)(row0 + ai * 128 + m * 16) * 1024 + col0;
#pragma unroll
        for (int bj = 0; bj < 2; ++bj)
#pragma unroll
          for (int n = 0; n < 2; ++n) {
            const f32x4 xv = *(const f32x4*)(src + ro + bj * 128 + n * 16);
            *(f32x4*)(dst + ro + bj * 128 + n * 16) = xv * DN_ALPHA + acc[ai][bj][m][n];
          }
      }
  }
};
template <class Epi>
DI void pg8_run(const u16* A, int lda, const u16* Bt, int N, int K, const Epi& E, char* smem) {
  pg8::Gemm g; g.A = A; g.Bt = Bt; g.M = T; g.N = N; g.K = K; g.lda = lda;
  pg8::StaticOrder S; S.init(T, N, (int)gridDim.x, (int)blockIdx.x);
  pg8::gemm_phase<Epi, pg8::StaticOrder, false>((PG8_LAS unsigned char*)smem, g, S, E, nullptr);
  __syncthreads();
}

DI float neg_expm1(float x) {
  if (x > -0.1f) return -x * (1.0f + x * (0.5f + x * ((1.0f / 6.0f) + x * ((1.0f / 24.0f) + x * (1.0f / 120.0f)))));
  return 1.0f - fast_exp(x);
}
DI void rglru_item(const Params& p, int item, char* smem) {
  char* ws = p.ws;
  const int hd = item & 7, bc = item >> 3, c = bc & 31, b = bc >> 5;
  const int t0 = b * SEQ + c * 128, s0 = c * 128;
  u16* Xc = (u16*)smem;
  u16* Was = (u16*)(smem + 18432);
  u16* Wxs = (u16*)(smem + 18432 + 9216);
  float* Xf = (float*)(smem + 36864);
  float* tend = (float*)(smem + 36864 + 33280);
  const int tid = tid_(), lane = tid & 63, w = tid >> 6, r = lane & 31, h = lane >> 5;
  const u16* proj0 = (const u16*)(ws + OFF_PROJ0);
  {
    const int cc = (tid & 7) * 8, ch = hd * 64 + cc;
    float cw[4][8], cb[8];
#pragma unroll
    for (int k = 0; k < 4; ++k)
#pragma unroll
      for (int e = 0; e < 8; ++e) cw[k][e] = p.ab_conv_w[k * 512 + ch + e];
#pragma unroll
    for (int e = 0; e < 8; ++e) cb[e] = p.ab_conv_b[ch + e];
#pragma unroll
    for (int i = 0; i < 2; ++i) {
      const int l = (tid >> 3) + 64 * i;
      float xc[8];
#pragma unroll
      for (int e = 0; e < 8; ++e) xc[e] = cb[e];
#pragma unroll
      for (int k = 0; k < 4; ++k) {
        const int s = s0 + l - 3 + k;
        if (s >= 0) {
          const u32x4 v = *(const u32x4*)(proj0 + (size_t)(t0 + l - 3 + k) * LD0 + ch);
          float f[8]; unpack8(v, f);
#pragma unroll
          for (int e = 0; e < 8; ++e) xc[e] += cw[k][e] * f[e];
        }
      }
      *(u32x4*)(Xc + l * GA_ST + cc) = pack8(xc);
#pragma unroll
      for (int e = 0; e < 8; ++e) Xf[l * 65 + cc + e] = xc[e];
    }
    const int j = tid >> 3;
    *(u32x4*)(Was + j * GA_ST + cc) = *(const u32x4*)((const u16*)(ws + OFF_WAT) + hd * 4096 + j * 64 + cc);
    *(u32x4*)(Wxs + j * GA_ST + cc) = *(const u32x4*)((const u16*)(ws + OFF_WXT) + hd * 4096 + j * 64 + cc);
  }
  __syncthreads();
  const int lt = w & 3, jt = w >> 2;
  f32x16 accA, accX;
#pragma unroll
  for (int e = 0; e < 16; ++e) { accA[e] = 0.f; accX[e] = 0.f; }
#pragma unroll
  for (int ks = 0; ks < 4; ++ks) {
    const bf16x8 af = ld_frag16(Xc + (lt * 32 + r) * GA_ST + ks * 16 + h * 8);
    const bf16x8 ba = ld_frag16(Was + (jt * 32 + r) * GA_ST + ks * 16 + h * 8);
    const bf16x8 bx = ld_frag16(Wxs + (jt * 32 + r) * GA_ST + ks * 16 + h * 8);
    accA = MFMA32(ba, af, accA); accX = MFMA32(bx, af, accX);
  }
  float Av[16], Bv[16];
#pragma unroll
  for (int i = 0; i < 16; ++i) {
    const int j = jt * 32 + crow(i, h), chg = hd * 64 + j;
    const float ra_ = sigmoidf_(accA[i] + p.ga_b[chg]);
    const float ix = sigmoidf_(accX[i] + p.gx_b[chg]);
    const float sp = ((const float*)(ws + OFF_SP))[chg];
    const float log_a = -8.0f * ra_ * sp;
    Av[i] = fast_exp(log_a);
    const float mult = sqrtf(neg_expm1(2.0f * log_a));
    Bv[i] = mult * ix * Xf[(lt * 32 + r) * 65 + j];
  }
#pragma unroll
  for (int d = 1; d < 32; d <<= 1) {
#pragma unroll
    for (int i = 0; i < 16; ++i) {
      const float Ap = __shfl_up(Av[i], d, 32), Bp = __shfl_up(Bv[i], d, 32);
      if (r >= d) { Bv[i] = Av[i] * Bp + Bv[i]; Av[i] = Av[i] * Ap; }
    }
  }
  if (r == 31) {
#pragma unroll
    for (int i = 0; i < 16; ++i) { const int j = jt * 32 + crow(i, h); tend[(lt * 64 + j) * 2] = Av[i]; tend[(lt * 64 + j) * 2 + 1] = Bv[i]; }
  }
  __syncthreads();
  const int t = t0 + lt * 32 + r;
  u16* hl = (u16*)(ws + OFF_HLOC) + (size_t)t * 512 + hd * 64;
  u16* pc = (u16*)(ws + OFF_PCUM) + (size_t)t * 512 + hd * 64;
  float hf[16], pf[16];
#pragma unroll
  for (int i = 0; i < 16; ++i) {
    const int j = jt * 32 + crow(i, h);
    float Hc = 0.f, Pp = 1.f;
    for (int tp = 0; tp < lt; ++tp) { const float Pe = tend[(tp * 64 + j) * 2], He = tend[(tp * 64 + j) * 2 + 1]; Hc = Pe * Hc + He; Pp *= Pe; }
    hf[i] = Bv[i] + Av[i] * Hc; pf[i] = Av[i] * Pp;
  }
#pragma unroll
  for (int g = 0; g < 4; ++g) {
    const int j = jt * 32 + 8 * g + 4 * h;
    u32x2 o; o.x = pk2(hf[4 * g], hf[4 * g + 1]); o.y = pk2(hf[4 * g + 2], hf[4 * g + 3]);
    *(u32x2*)(hl + j) = o;
    o.x = pk2(pf[4 * g], pf[4 * g + 1]); o.y = pk2(pf[4 * g + 2], pf[4 * g + 3]);
    *(u32x2*)(pc + j) = o;
  }
  if (lt == 3 && r == 31) {
    float* he = (float*)(ws + OFF_HEND) + (size_t)(b * 32 + c) * 512 + hd * 64;
    float* pe = (float*)(ws + OFF_PEND) + (size_t)(b * 32 + c) * 512 + hd * 64;
#pragma unroll
    for (int i = 0; i < 16; ++i) { const int j = jt * 32 + crow(i, h); he[j] = hf[i]; pe[j] = pf[i]; }
  }
  __syncthreads();
}

DI void krope_item(const Params& p, int item) {
  char* ws = p.ws;
  const u16* proj0 = (const u16*)(ws + OFF_PROJ0);
  const float* ct = (const float*)(ws + OFF_COS); const float* st = (const float*)(ws + OFF_SIN);
  u16* kc = (u16*)(ws + OFF_KC);
#pragma unroll
  for (int i = 0; i < 8; ++i) {
    const int u = tid_() + NT * i, tl = u >> 4, j = u & 15, t = item * 256 + tl;
    const float x1 = bf2f(proj0[(size_t)t * LD0 + 1920 + j]), x2 = bf2f(proj0[(size_t)t * LD0 + 1936 + j]);
    const float c = ct[(size_t)t * 16 + j], s = st[(size_t)t * 16 + j];
    const u16 o1 = f2bf(x1 * c - x2 * s), o2 = f2bf(x2 * c + x1 * s);
#pragma unroll
    for (int hh = 0; hh < 8; ++hh) { kc[(size_t)t * 768 + hh * 96 + 64 + j] = o1; kc[(size_t)t * 768 + hh * 96 + 80 + j] = o2; }
  }
}

constexpr int KS_ST = 104, VS_ST = 72;
DI void attn_item(const Params& p, int bh, int qb, char* smem) {
  char* ws = p.ws;
  const int b = bh >> 3, hh = bh & 7;
  u16* Ks = (u16*)smem;
  u16* Vs = (u16*)(smem + 2 * 64 * KS_ST * 2);
  const int tid = tid_(), lane = tid & 63, w = tid >> 6, r = lane & 31, h = lane >> 5;
  const int q0 = qb * 256, qw = q0 + w * 32, sq = qw + r;
  const size_t t = (size_t)b * SEQ + sq;
  const u16* Q = (const u16*)(ws + OFF_Q);
  const u16* Kc = (const u16*)(ws + OFF_KC) + (size_t)b * SEQ * 768 + hh * 96;
  const u16* Vt = (const u16*)(ws + OFF_VT) + (size_t)bh * 64 * SEQ;
  bf16x8 qf[6];
#pragma unroll
  for (int s = 0; s < 6; ++s) qf[s] = ld_frag16(Q + t * 768 + hh * 96 + s * 16 + h * 8);
  f32x16 o0, o1;
#pragma unroll
  for (int e = 0; e < 16; ++e) { o0[e] = 0.f; o1[e] = 0.f; }
  float m = -1e30f, l = 0.f;
  const int nkt = 4 * (qb + 1);
  const int c0 = tid, c1 = tid + NT;
  const int kr0 = c0 / 12, kc0 = (c0 % 12) * 8, kr1 = c1 / 12, kc1 = (c1 % 12) * 8;
  const bool has1 = c1 < 768;
  const int vd = tid >> 3, vk = (tid & 7) * 8;
  u32x4 rk0, rk1, rv;
  auto gload = [&](int kt) {
    const int k0 = kt * 64;
    rk0 = *(const u32x4*)(Kc + (size_t)(k0 + kr0) * 768 + kc0);
    if (has1) rk1 = *(const u32x4*)(Kc + (size_t)(k0 + kr1) * 768 + kc1);
    rv = *(const u32x4*)(Vt + (size_t)vd * SEQ + k0 + vk);
  };
  auto lstore = [&](int buf) {
    u16* ks = Ks + buf * 64 * KS_ST; u16* vs = Vs + buf * 64 * VS_ST;
    *(u32x4*)(ks + kr0 * KS_ST + kc0) = rk0;
    if (has1) *(u32x4*)(ks + kr1 * KS_ST + kc1) = rk1;
    *(u32x4*)(vs + vd * VS_ST + vk) = rv;
  };
  gload(0); lstore(0);
  __syncthreads();
  for (int kt = 0; kt < nkt; ++kt) {
    const int buf = kt & 1, k0 = kt * 64;
    if (kt + 1 < nkt) gload(kt + 1);
    if (k0 <= qw + 31) {
      const u16* ks = Ks + buf * 64 * KS_ST; const u16* vs = Vs + buf * 64 * VS_ST;
      f32x16 st0, st1;
#pragma unroll
      for (int e = 0; e < 16; ++e) { st0[e] = 0.f; st1[e] = 0.f; }
#pragma unroll
      for (int s = 0; s < 6; ++s) {
        const bf16x8 k0f = ld_frag16(ks + r * KS_ST + s * 16 + h * 8);
        const bf16x8 k1f = ld_frag16(ks + (32 + r) * KS_ST + s * 16 + h * 8);
        st0 = MFMA32(k0f, qf[s], st0); st1 = MFMA32(k1f, qf[s], st1);
      }
      if (k0 + 63 > qw) {
#pragma unroll
        for (int i = 0; i < 16; ++i) {
          const int key = k0 + crow(i, h);
          if (key > sq) st0[i] = -1e30f;
          if (key + 32 > sq) st1[i] = -1e30f;
        }
      }
      float mx = st0[0];
#pragma unroll
      for (int i = 1; i < 16; ++i) mx = fmaxf(mx, st0[i]);
#pragma unroll
      for (int i = 0; i < 16; ++i) mx = fmaxf(mx, st1[i]);
      mx = fmaxf(mx, __shfl_xor(mx, 32));
      const float mn = fmaxf(m, mx), alpha = fast_exp2(m - mn);
      float ls = 0.f;
#pragma unroll
      for (int i = 0; i < 16; ++i) { st0[i] = fast_exp2(st0[i] - mn); st1[i] = fast_exp2(st1[i] - mn); ls += st0[i] + st1[i]; }
      l = l * alpha + ls; m = mn;
#pragma unroll
      for (int e = 0; e < 16; ++e) { o0[e] *= alpha; o1[e] *= alpha; }
#pragma unroll
      for (int s = 0; s < 2; ++s) {
        const bf16x8 p0 = pack_frag(st0, s), p1 = pack_frag(st1, s);
        {
          const u16* v0 = vs + r * VS_ST + 16 * s + 4 * h;
          const bf16x8 va = ld_frag8x2(v0, v0 + 8), vb = ld_frag8x2(v0 + 32 * VS_ST, v0 + 32 * VS_ST + 8);
          o0 = MFMA32(va, p0, o0); o1 = MFMA32(vb, p0, o1);
        }
        {
          const u16* v1 = vs + r * VS_ST + 32 + 16 * s + 4 * h;
          const bf16x8 va = ld_frag8x2(v1, v1 + 8), vb = ld_frag8x2(v1 + 32 * VS_ST, v1 + 32 * VS_ST + 8);
          o0 = MFMA32(va, p1, o0); o1 = MFMA32(vb, p1, o1);
        }
      }
    }
    if (kt + 1 < nkt) lstore(buf ^ 1);
    __syncthreads();
  }
  const float lt = l + __shfl_xor(l, 32), inv = 1.0f / lt;
  const u16* sg = (const u16*)(ws + OFF_PROJ0) + t * LD0 + 1024 + hh * 64;
  u16* yc = (u16*)(ws + OFF_YCAT) + t * 1024 + 512 + hh * 64;
#pragma unroll
  for (int dt = 0; dt < 2; ++dt)
#pragma unroll
    for (int g = 0; g < 4; ++g) {
      const int d = dt * 32 + 8 * g + 4 * h;
      const u32x2 gv = *(const u32x2*)(sg + d);
      const f32x16& o = dt ? o1 : o0;
      u32x2 ov;
      ov.x = pk2(o[4 * g] * inv * bflo(gv.x), o[4 * g + 1] * inv * bfhi(gv.x));
      ov.y = pk2(o[4 * g + 2] * inv * bflo(gv.y), o[4 * g + 3] * inv * bfhi(gv.y));
      *(u32x2*)(yc + d) = ov;
    }
}

DI void fixup_item(const Params& p, int item, char* smem) {
  char* ws = p.ws;
  const int b = item >> 5, c = item & 31, tid = tid_();
  float* Hin = (float*)smem;
  {
    const float* he = (const float*)(ws + OFF_HEND) + (size_t)(b * 32) * 512 + tid;
    const float* pe = (const float*)(ws + OFF_PEND) + (size_t)(b * 32) * 512 + tid;
    float H = 0.f;
    int cp = 0;
    for (; cp + 8 <= c; cp += 8) {
      float pv[8], hv[8];
#pragma unroll
      for (int k = 0; k < 8; ++k) { pv[k] = pe[(cp + k) * 512]; hv[k] = he[(cp + k) * 512]; }
#pragma unroll
      for (int k = 0; k < 8; ++k) H = pv[k] * H + hv[k];
    }
    for (; cp < c; ++cp) H = pe[cp * 512] * H + he[cp * 512];
    Hin[tid] = H;
  }
  __syncthreads();
  const size_t t0 = (size_t)b * SEQ + c * 128;
  const u16* hl = (const u16*)(ws + OFF_HLOC); const u16* pc = (const u16*)(ws + OFF_PCUM);
  const u16* proj0 = (const u16*)(ws + OFF_PROJ0); u16* yc = (u16*)(ws + OFF_YCAT);
#pragma unroll 4
  for (int i = 0; i < 16; ++i) {
    const int u = tid + NT * i, l = u >> 6, cc = (u & 63) * 8;
    const size_t tt = t0 + l;
    const u32x4 hv = *(const u32x4*)(hl + tt * 512 + cc), pv = *(const u32x4*)(pc + tt * 512 + cc), gv = *(const u32x4*)(proj0 + tt * LD0 + 512 + cc);
    float hf[8], pf[8], gf[8], o[8];
    unpack8(hv, hf); unpack8(pv, pf); unpack8(gv, gf);
#pragma unroll
    for (int e = 0; e < 8; ++e) o[e] = (hf[e] + pf[e] * Hin[cc + e]) * gf[e];
    *(u32x4*)(yc + tt * 1024 + cc) = pack8(o);
  }
  __syncthreads();
}

DI void ln_phase(const Params& p, const float* __restrict__ g, const float* __restrict__ bta, u16* xb) {
  const int lane = tid_() & 63, gw = blockIdx.x * 8 + (tid_() >> 6), nw = gridDim.x * 8;
  f32x4 gg[4], bb[4];
#pragma unroll
  for (int i = 0; i < 4; ++i) { gg[i] = *(const f32x4*)(g + i * 256 + lane * 4); bb[i] = *(const f32x4*)(bta + i * 256 + lane * 4); }
  for (int row = gw; row < T; row += nw) {
    float* pr = p.out + (size_t)row * 1024;
    f32x4 v[4];
    float s = 0.f;
#pragma unroll
    for (int i = 0; i < 4; ++i) { v[i] = *(const f32x4*)(pr + i * 256 + lane * 4); s += (v[i].x + v[i].y) + (v[i].z + v[i].w); }
#pragma unroll
    for (int d = 1; d < 64; d <<= 1) s += __shfl_xor(s, d);
    const float mu = s * (1.0f / 1024.0f);
    float q = 0.f;
#pragma unroll
    for (int i = 0; i < 4; ++i) { v[i].x -= mu; v[i].y -= mu; v[i].z -= mu; v[i].w -= mu; q += (v[i].x * v[i].x + v[i].y * v[i].y) + (v[i].z * v[i].z + v[i].w * v[i].w); }
#pragma unroll
    for (int d = 1; d < 64; d <<= 1) q += __shfl_xor(q, d);
    const float rstd = rsqrtf(q * (1.0f / 1024.0f) + 1e-5f);
#pragma unroll
    for (int i = 0; i < 4; ++i) {
      f32x4 o;
      o.x = v[i].x * rstd * gg[i].x + bb[i].x; o.y = v[i].y * rstd * gg[i].y + bb[i].y; o.z = v[i].z * rstd * gg[i].z + bb[i].z; o.w = v[i].w * rstd * gg[i].w + bb[i].w;
      *(f32x4*)(pr + i * 256 + lane * 4) = o;
      if (xb) { u32x2 w; w.x = pk2(o.x, o.y); w.y = pk2(o.z, o.w); *(u32x2*)(xb + (size_t)row * 1024 + i * 256 + lane * 4) = w; }
    }
  }
}

DI void ssdprep_phase(const Params& p) {
  char* ws = p.ws;
  const int tid = tid_(), lane = tid & 63;
  {
    float* dtb = (float*)(ws + OFF_DT); float* csb = (float*)(ws + OFF_CS);
    const int gw = blockIdx.x * 8 + (tid >> 6), nw = gridDim.x * 8;
    for (int it = gw; it < 8192; it += nw) {
      const int hd = it & 31, bc = it >> 5;
      const size_t t0 = (size_t)bc * 128;
      const float a_neg = -expf(p.a_log[hd]), dtbias = p.dt_bias[hd];
      const float r0 = dtb[(t0 + 2 * lane) * 32 + hd] + dtbias, r1 = dtb[(t0 + 2 * lane + 1) * 32 + hd] + dtbias;
      const float d0 = fmaxf(r0, 0.f) + log1pf(expf(-fabsf(r0))), d1 = fmaxf(r1, 0.f) + log1pf(expf(-fabsf(r1)));
      const float a0 = d0 * a_neg, a1 = d1 * a_neg;
      float s = a0 + a1;
#pragma unroll
      for (int d = 1; d < 64; d <<= 1) { const float o = __shfl_up(s, d, 64); if (lane >= d) s += o; }
      dtb[(t0 + 2 * lane) * 32 + hd] = d0; dtb[(t0 + 2 * lane + 1) * 32 + hd] = d1;
      csb[(t0 + 2 * lane) * 32 + hd] = s - a1; csb[(t0 + 2 * lane + 1) * 32 + hd] = s;
    }
  }
  {
    u16* X = (u16*)(ws + OFF_XBC); const u16* H = (const u16*)(ws + OFF_HALO);
    const size_t gid = (size_t)blockIdx.x * NT + tid, gstride = (size_t)gridDim.x * NT;
    for (size_t task = gid; task < (size_t)512 * 384; task += gstride) {
      const int cg = (int)(task % 384), rt = (int)(task / 384), ch = cg * 8;
      float cw[4][8], cb[8];
#pragma unroll
      for (int k = 0; k < 4; ++k)
#pragma unroll
        for (int e = 0; e < 8; ++e) cw[k][e] = p.ssd_conv_w[k * 3072 + ch + e];
#pragma unroll
      for (int e = 0; e < 8; ++e) cb[e] = p.ssd_conv_b[ch + e];
      float w0[8], w1[8], w2[8];
      if ((rt & 63) == 0) {
#pragma unroll
        for (int e = 0; e < 8; ++e) { w0[e] = 0.f; w1[e] = 0.f; w2[e] = 0.f; }
      } else {
        const u16* hp = H + (size_t)(rt - 1) * 3 * 3072 + ch;
        unpack8(*(const u32x4*)(hp), w0); unpack8(*(const u32x4*)(hp + 3072), w1); unpack8(*(const u32x4*)(hp + 2 * 3072), w2);
      }
      u16* xp = X + (size_t)rt * 64 * 3072 + ch;
      for (int r8 = 0; r8 < 64; r8 += 8) {
        u32x4 raw[8];
#pragma unroll
        for (int i = 0; i < 8; ++i) raw[i] = *(const u32x4*)(xp + (size_t)(r8 + i) * 3072);
#pragma unroll
        for (int i = 0; i < 8; ++i) {
          float f[8], o[8]; unpack8(raw[i], f);
#pragma unroll
          for (int e = 0; e < 8; ++e) {
            o[e] = siluf_(cb[e] + cw[0][e] * w0[e] + cw[1][e] * w1[e] + cw[2][e] * w2[e] + cw[3][e] * f[e]);
            w0[e] = w1[e]; w1[e] = w2[e]; w2[e] = f[e];
          }
          *(u32x4*)(xp + (size_t)(r8 + i) * 3072) = pack8(o);
        }
      }
    }
  }
}

DI void ygscale_phase(const Params& p) {
  char* ws = p.ws;
  u16* yg = (u16*)(ws + OFF_Z); const float* ss = (const float*)(ws + OFF_SS);
  const size_t gid = (size_t)blockIdx.x * NT + tid_(), gstride = (size_t)gridDim.x * NT;
  for (size_t u = gid; u < (size_t)T * 256; u += gstride) {
    const size_t t = u >> 8; const int c8 = (int)(u & 255) * 8;
    const float rs = rsqrtf(ss[t * 4 + (c8 >> 9)] * (1.0f / 512.0f) + 1e-6f);
    u32x4* ptr = (u32x4*)(yg + t * 2048 + c8);
    float f[8]; unpack8(*ptr, f);
#pragma unroll
    for (int e = 0; e < 8; ++e) f[e] *= rs;
    *ptr = pack8(f);
  }
}

constexpr int SS_ST = 136;
DI void ssd_item(const Params& p, int item, char* smem) {
  char* ws = p.ws;
  const int b = item >> 5, hd = item & 31, g = hd >> 3;
  u16* Cs = (u16*)smem;
  u16* Bs = (u16*)(smem + 34816);
  u16* Bd = (u16*)(smem + 2 * 34816);
  u16* Xt = (u16*)(smem + 3 * 34816);
  u16* St = (u16*)(smem + 3 * 34816 + 17408);
  u16* Xs = (u16*)(smem + 3 * 34816 + 2 * 17408);
  float* cs = (float*)(smem + 3 * 34816 + 2 * 17408 + 18432);
  const int tid = tid_(), lane = tid & 63, w = tid >> 6, r = lane & 31, h = lane >> 5;
  const float Dh = p.ssd_d[hd];
  u16* Zb = (u16*)(ws + OFF_Z);
  const u16* Xg = (const u16*)(ws + OFF_XBC);
  const float* dtb = (const float*)(ws + OFF_DT);
  const float* csb = (const float*)(ws + OFF_CS);
  float* ssb = (float*)(ws + OFF_SS);
  const int xcc = (tid & 7) * 8, xl = tid >> 3;
  const int bcc = (tid & 15) * 8, bl = tid >> 4;
  f32x16 stacc;
#pragma unroll
  for (int e = 0; e < 16; ++e) stacc[e] = 0.f;
  for (int i = tid; i < 64 * SS_ST / 2; i += NT) ((unsigned*)St)[i] = 0u;
  const int lt = (w < 4) ? w : 7 - w, pt = w >> 2, nt = w & 3;
  u32x4 px[2], pb[4], pc[4];
  float pdt[2], pcs[4], pcsT, pcl;
  auto prefetch = [&](int c) {
    const size_t t0 = (size_t)b * SEQ + c * 128;
#pragma unroll
    for (int i = 0; i < 2; ++i) {
      px[i] = *(const u32x4*)(Xg + (t0 + xl + 64 * i) * 3072 + hd * 64 + xcc);
      pdt[i] = dtb[(t0 + xl + 64 * i) * 32 + hd];
    }
#pragma unroll
    for (int i = 0; i < 4; ++i) {
      pb[i] = *(const u32x4*)(Xg + (t0 + bl + 32 * i) * 3072 + 2048 + g * 128 + bcc);
      pc[i] = *(const u32x4*)(Xg + (t0 + bl + 32 * i) * 3072 + 2560 + g * 128 + bcc);
      pcs[i] = csb[(t0 + bl + 32 * i) * 32 + hd];
    }
    pcsT = csb[(t0 + 127) * 32 + hd];
    pcl = csb[(t0 + (tid & 127)) * 32 + hd];
  };
  prefetch(0);
  for (int c = 0; c < 32; ++c) {
    const size_t t0 = (size_t)b * SEQ + c * 128;
    const float csT = pcsT;
    if (tid < 128) cs[tid] = pcl;
#pragma unroll
    for (int i = 0; i < 2; ++i) {
      const int l = xl + 64 * i;
      *(u32x4*)(Xs + l * GA_ST + xcc) = px[i];
      float f[8]; unpack8(px[i], f);
#pragma unroll
      for (int e = 0; e < 8; ++e) Xt[(xcc + e) * SS_ST + l] = f2bf(f[e] * pdt[i]);
    }
#pragma unroll
    for (int i = 0; i < 4; ++i) {
      const int l = bl + 32 * i;
      *(u32x4*)(Bs + l * SS_ST + bcc) = pb[i];
      *(u32x4*)(Cs + l * SS_ST + bcc) = pc[i];
      const float dec = fast_exp(csT - pcs[i]);
      float f[8]; unpack8(pb[i], f);
#pragma unroll
      for (int e = 0; e < 8; ++e) Bd[(bcc + e) * SS_ST + l] = f2bf(f[e] * dec);
    }
    __syncthreads();
    {
      const int l = lt * 32 + r;
      const size_t t = t0 + l;
      u16* zrow = Zb + t * 2048 + hd * 64;
      u32x2 zv[4];
#pragma unroll
      for (int gq = 0; gq < 4; ++gq) zv[gq] = *(const u32x2*)(zrow + pt * 32 + 8 * gq + 4 * h);
      if (c + 1 < 32) prefetch(c + 1);
      const float csl = cs[l];
      f32x16 yd, yo;
#pragma unroll
      for (int e = 0; e < 16; ++e) { yd[e] = 0.f; yo[e] = 0.f; }
      for (int st = 0; st <= lt; ++st) {
        f32x16 cb_;
#pragma unroll
        for (int e = 0; e < 16; ++e) cb_[e] = 0.f;
#pragma unroll
        for (int ks = 0; ks < 8; ++ks) {
          const bf16x8 bf = ld_frag16(Bs + (st * 32 + r) * SS_ST + ks * 16 + h * 8);
          const bf16x8 cf = ld_frag16(Cs + l * SS_ST + ks * 16 + h * 8);
          cb_ = MFMA32(bf, cf, cb_);
        }
#pragma unroll
        for (int i = 0; i < 16; ++i) {
          const int s = st * 32 + crow(i, h);
          const float dec = fast_exp(csl - cs[s]);
          cb_[i] = (s <= l) ? cb_[i] * dec : 0.f;
        }
#pragma unroll
        for (int s2 = 0; s2 < 2; ++s2) {
          const bf16x8 pf = pack_frag(cb_, s2);
          const u16* x0 = Xt + (pt * 32 + r) * SS_ST + st * 32 + 16 * s2 + 4 * h;
          const bf16x8 xf = ld_frag8x2(x0, x0 + 8);
          yd = MFMA32(xf, pf, yd);
        }
      }
#pragma unroll
      for (int ks = 0; ks < 8; ++ks) {
        const bf16x8 sf = ld_frag16(St + (pt * 32 + r) * SS_ST + ks * 16 + h * 8);
        const bf16x8 cf = ld_frag16(Cs + l * SS_ST + ks * 16 + h * 8);
        yo = MFMA32(sf, cf, yo);
      }
      const float el = fast_exp(csl);
      float ssq = 0.f;
#pragma unroll
      for (int gq = 0; gq < 4; ++gq) {
        const int pb_ = pt * 32 + 8 * gq + 4 * h;
        const u32x2 xv = *(const u32x2*)(Xs + l * GA_ST + pb_);
        const float y0 = (yd[4 * gq] + el * yo[4 * gq] + Dh * bflo(xv.x)) * bflo(zv[gq].x);
        const float y1 = (yd[4 * gq + 1] + el * yo[4 * gq + 1] + Dh * bfhi(xv.x)) * bfhi(zv[gq].x);
        const float y2 = (yd[4 * gq + 2] + el * yo[4 * gq + 2] + Dh * bflo(xv.y)) * bflo(zv[gq].y);
        const float y3 = (yd[4 * gq + 3] + el * yo[4 * gq + 3] + Dh * bfhi(xv.y)) * bfhi(zv[gq].y);
        ssq += (y0 * y0 + y1 * y1) + (y2 * y2 + y3 * y3);
        u32x2 ov; ov.x = pk2(y0, y1); ov.y = pk2(y2, y3);
        *(u32x2*)(zrow + pb_) = ov;
      }
      ssq += __shfl_xor(ssq, 32);
      if (h == 0) atomicAdd(ssb + t * 4 + g, ssq);
    }
    {
      const float dT = fast_exp(csT);
#pragma unroll
      for (int e = 0; e < 16; ++e) stacc[e] *= dT;
#pragma unroll
      for (int ks = 0; ks < 8; ++ks) {
        const bf16x8 bf = ld_frag16(Bd + (nt * 32 + r) * SS_ST + ks * 16 + h * 8);
        const bf16x8 xf = ld_frag16(Xt + (pt * 32 + r) * SS_ST + ks * 16 + h * 8);
        stacc = MFMA32(bf, xf, stacc);
      }
    }
    __syncthreads();
#pragma unroll
    for (int gq = 0; gq < 4; ++gq) {
      u32x2 ov; ov.x = pk2(stacc[4 * gq], stacc[4 * gq + 1]); ov.y = pk2(stacc[4 * gq + 2], stacc[4 * gq + 3]);
      *(u32x2*)(St + (pt * 32 + r) * SS_ST + nt * 32 + 8 * gq + 4 * h) = ov;
    }
  }
  __syncthreads();
}

__global__ void __launch_bounds__(NT) fwd_megakernel(Params p) {
  __shared__ __attribute__((aligned(16))) char smem[160 * 1024];
  cg::grid_group grid = cg::this_grid();
  char* ws = p.ws;
  const int nb = gridDim.x, bid = blockIdx.x;
  int rot = 0;
  phase_prep(p, smem);
  grid.sync();
  { EpiProj0 E; E.O = (u16*)(ws + OFF_PROJ0); pg8_run((const u16*)(ws + OFF_XB), 1024, (const u16*)(ws + OFF_W1T), 2048, 1024, E, smem); }
  grid.sync();
  for (int it = (bid + nb - rot) % nb; it < 2048; it += nb) rglru_item(p, it, smem);
  rot = (rot + 2048) % nb;
  gemm_phase<2>(p, (const u16*)(ws + OFF_PROJ0) + 1536, LD0, (const u16*)(ws + OFF_WQT), 256, 768, rot, smem);
  gemm_phase<3>(p, (const u16*)(ws + OFF_PROJ0) + 1792, LD0, (const u16*)(ws + OFF_WKVT), 128, 1024, rot, smem);
  for (int it = (bid + nb - rot) % nb; it < 128; it += nb) krope_item(p, it);
  rot = (rot + 128) % nb;
  grid.sync();
  for (int it = bid; it < 1024; it += nb) {
    const int j = it & 255, i = it >> 8, g = j >> 6, bh = j & 63;
    const int qb = (i == 0) ? 15 - g : (i == 1) ? 8 + g : (i == 2) ? 7 - g : g;
    attn_item(p, bh, qb, smem);
  }
  for (int it = bid; it < 256; it += nb) fixup_item(p, it, smem);
  grid.sync();
  rot = 0;
  { EpiResid<false> E; E.src = p.x; E.dst = p.out; E.ss = nullptr; pg8_run((const u16*)(ws + OFF_YCAT), 1024, (const u16*)(ws + OFF_WOT), 1024, 1024, E, smem); }
  grid.sync();
  ln_phase(p, p.ab_ln_g, p.ab_ln_b, (u16*)(ws + OFF_X1B));
  grid.sync();
  rot = 0;
  { EpiProj1 E; E.Z = (u16*)(ws + OFF_Z); E.X = (u16*)(ws + OFF_XBC); E.H = (u16*)(ws + OFF_HALO); E.dt = (float*)(ws + OFF_DT); pg8_run((const u16*)(ws + OFF_X1B), 1024, (const u16*)(ws + OFF_W2T), 5376, 1024, E, smem); }
  grid.sync();
  ssdprep_phase(p);
  grid.sync();
  for (int it = bid; it < 256; it += nb) ssd_item(p, it, smem);
  grid.sync();
  ygscale_phase(p);
  grid.sync();
  rot = 0;
  { EpiResid<false> E; E.src = p.out; E.dst = p.out; E.ss = nullptr; pg8_run((const u16*)(ws + OFF_Z), 2048, (const u16*)(ws + OFF_W3T), 1024, 2048, E, smem); }
  grid.sync();
  ln_phase(p, p.ssd_ln_g, p.ssd_ln_b, nullptr);
}

extern "C" void kernel_launch(void* const* d_in, const int* in_sizes, int n_in, void* d_out, int out_size, void* d_ws, size_t ws_size, hipStream_t stream) {
  static int grid_blocks = 0;
  if (!grid_blocks) {
    int dev = 0, cus = 0, per_cu = 0;
    hipGetDevice(&dev);
    hipDeviceGetAttribute(&cus, hipDeviceAttributeMultiprocessorCount, dev);
    hipOccupancyMaxActiveBlocksPerMultiprocessor(&per_cu, fwd_megakernel, NT, 0);
    if (per_cu < 1) per_cu = 1;
    grid_blocks = cus * per_cu;
  }
  Params p{};
  p.x = (const float*)d_in[0]; p.pos = (const int*)d_in[1];
  p.ab_w_in = (const float*)d_in[2]; p.ab_conv_w = (const float*)d_in[3]; p.ab_conv_b = (const float*)d_in[4];
  p.ga_w = (const float*)d_in[5]; p.ga_b = (const float*)d_in[6]; p.gx_w = (const float*)d_in[7]; p.gx_b = (const float*)d_in[8];
  p.lam = (const float*)d_in[9]; p.qn = (const float*)d_in[10]; p.kvn = (const float*)d_in[11]; p.w_uq = (const float*)d_in[12];
  p.w_ukv = (const float*)d_in[13]; p.ab_w_out = (const float*)d_in[14]; p.ab_ln_g = (const float*)d_in[15]; p.ab_ln_b = (const float*)d_in[16];
  p.ssd_w_in = (const float*)d_in[17]; p.ssd_conv_w = (const float*)d_in[18]; p.ssd_conv_b = (const float*)d_in[19]; p.dt_bias = (const float*)d_in[20];
  p.a_log = (const float*)d_in[21]; p.ssd_d = (const float*)d_in[22]; p.ssd_norm = (const float*)d_in[23]; p.ssd_w_out = (const float*)d_in[24];
  p.ssd_ln_g = (const float*)d_in[25]; p.ssd_ln_b = (const float*)d_in[26];
  p.out = (float*)d_out; p.ws = (char*)d_ws;
  void* args[] = {&p};
  hipError_t e = hipLaunchCooperativeKernel((void*)fwd_megakernel, dim3(grid_blocks), dim3(NT), args, 0, stream);
  if (e != hipSuccess) fprintf(stderr, "cooperative launch failed: %s (grid %d)\n", hipGetErrorString(e), grid_blocks);
}
```

```cpp
#include <hip/hip_runtime.h>
#include <hip/hip_cooperative_groups.h>
#include <cstdio>
namespace cg = cooperative_groups;

typedef unsigned short u16;
typedef short bf16x8 __attribute__((ext_vector_type(8)));
typedef short s16x4 __attribute__((ext_vector_type(4)));
typedef float f32x16 __attribute__((ext_vector_type(16)));
typedef float f32x4 __attribute__((ext_vector_type(4)));
typedef unsigned u32x4 __attribute__((ext_vector_type(4)));
typedef unsigned u32x2 __attribute__((ext_vector_type(2)));
typedef __bf16 bf2_t __attribute__((ext_vector_type(2)));

#define DI __device__ __forceinline__
#define NT 512
__device__ __forceinline__ int tid_() { int t = threadIdx.x; asm volatile("" : "+v"(t)); return t; }
#define MFMA32(a, b, c) __builtin_amdgcn_mfma_f32_32x32x16_bf16((a), (b), (c), 0, 0, 0)

constexpr int T = 32768, SEQ = 4096;
constexpr float DN_ALPHA = 1.41421356237309515f;
constexpr size_t Mi = 1024ull * 1024ull;
constexpr size_t OFF_W1T = 0, OFF_WOT = 4 * Mi, OFF_W2T = 6 * Mi, OFF_W3T = 16 * Mi + 512 * 1024, OFF_WQT = 20 * Mi + 512 * 1024,
                 OFF_WKVT = 21 * Mi, OFF_WAT = 21 * Mi + 256 * 1024, OFF_WXT = 21 * Mi + 320 * 1024, OFF_COS = 21 * Mi + 512 * 1024,
                 OFF_SIN = 23 * Mi + 512 * 1024, OFF_HEND = 25 * Mi + 512 * 1024, OFF_PEND = 26 * Mi, OFF_SS = 26 * Mi + 512 * 1024,
                 OFF_DT = 27 * Mi, OFF_XB = 32 * Mi, OFF_YCAT = 32 * Mi, OFF_X1B = 32 * Mi, OFF_BC = 32 * Mi, OFF_PROJ0 = 96 * Mi,
                 OFF_HLOC = 224 * Mi, OFF_PCUM = 256 * Mi, OFF_Q = 288 * Mi, OFF_KC = 336 * Mi, OFF_VT = 384 * Mi, OFF_PROJ1 = 96 * Mi,
                 OFF_Z = 96 * Mi, OFF_XBC = 224 * Mi, OFF_HALO = 416 * Mi, OFF_CS = 428 * Mi, OFF_SP = 31 * Mi, OFF_BAR = 31 * Mi + 65536;
constexpr int LD0 = 2048, LD1 = 5376;

struct Params {
  const float* x; const int* pos;
  const float *ab_w_in, *ab_conv_w, *ab_conv_b, *ga_w, *ga_b, *gx_w, *gx_b, *lam, *qn, *kvn, *w_uq, *w_ukv, *ab_w_out, *ab_ln_g, *ab_ln_b;
  const float *ssd_w_in, *ssd_conv_w, *ssd_conv_b, *dt_bias, *a_log, *ssd_d, *ssd_norm, *ssd_w_out, *ssd_ln_g, *ssd_ln_b;
  float* out; char* ws;
};

DI unsigned pk2(float a, float b) { bf2_t v; v[0] = (__bf16)a; v[1] = (__bf16)b; return __builtin_bit_cast(unsigned, v); }
DI u16 f2bf(float a) { __bf16 v = (__bf16)a; return __builtin_bit_cast(u16, v); }
DI float bflo(unsigned w) { return __uint_as_float(w << 16); }
DI float bfhi(unsigned w) { return __uint_as_float(w & 0xffff0000u); }
DI float bf2f(u16 v) { return __uint_as_float(((unsigned)v) << 16); }
DI float fast_exp2(float x) { return __builtin_amdgcn_exp2f(x); }
DI float fast_exp(float x) { return __builtin_amdgcn_exp2f(x * 1.44269504088896341f); }
DI float fast_rcp(float x) { return __builtin_amdgcn_rcpf(x); }
DI float sigmoidf_(float x) { return fast_rcp(1.0f + fast_exp(-x)); }
DI float siluf_(float x) { return x * sigmoidf_(x); }
DI int crow(int i, int h) { return (i & 3) + 8 * (i >> 2) + 4 * h; }
DI void unpack8(const u32x4& v, float* f) {
  f[0] = bflo(v.x); f[1] = bfhi(v.x); f[2] = bflo(v.y); f[3] = bfhi(v.y); f[4] = bflo(v.z); f[5] = bfhi(v.z); f[6] = bflo(v.w); f[7] = bfhi(v.w);
}
DI u32x4 pack8(const float* f) { u32x4 v; v.x = pk2(f[0], f[1]); v.y = pk2(f[2], f[3]); v.z = pk2(f[4], f[5]); v.w = pk2(f[6], f[7]); return v; }
DI bf16x8 pack_frag(const f32x16& x, int s) {
  u32x4 v; v.x = pk2(x[8 * s], x[8 * s + 1]); v.y = pk2(x[8 * s + 2], x[8 * s + 3]); v.z = pk2(x[8 * s + 4], x[8 * s + 5]); v.w = pk2(x[8 * s + 6], x[8 * s + 7]);
  return __builtin_bit_cast(bf16x8, v);
}
DI bf16x8 ld_frag16(const u16* p) { return *(const bf16x8*)p; }
DI bf16x8 ld_frag8x2(const u16* p0, const u16* p1) {
  s16x4 lo = *(const s16x4*)p0, hi = *(const s16x4*)p1;
  return __builtin_shufflevector(lo, hi, 0, 1, 2, 3, 4, 5, 6, 7);
}

DI void tr_tile(const float* __restrict__ src, u16* __restrict__ dst, int K, int N, const float* __restrict__ scale, int kt, int nt, char* smem) {
  float* tf = (float*)smem;
  const int tid = tid_(), k0 = kt * 64, n0 = nt * 64;
#pragma unroll
  for (int i = 0; i < 8; ++i) {
    const int kk = (tid >> 6) + 8 * i, nn = tid & 63;
    float v = 0.f;
    if (n0 + nn < N) { v = src[(size_t)(k0 + kk) * N + n0 + nn]; if (scale) v *= scale[k0 + kk]; }
    tf[kk * 65 + nn] = v;
  }
  __syncthreads();
#pragma unroll
  for (int i = 0; i < 8; ++i) {
    const int nn = (tid >> 6) + 8 * i, kk = tid & 63;
    dst[(size_t)(n0 + nn) * K + k0 + kk] = f2bf(tf[kk * 65 + nn]);
  }
  __syncthreads();
}
DI void tr_job(const float* src, u16* dst, int K, int N, int Npad, const float* scale, int& rot, char* smem) {
  const int nkt = K / 64, nnt = Npad / 64, n = nkt * nnt, nb = gridDim.x;
  for (int it = (blockIdx.x + nb - rot) % nb; it < n; it += nb) tr_tile(src, dst, K, N, scale, it % nkt, it / nkt, smem);
  rot = (rot + n) % nb;
}

DI void phase_prep(const Params& p, char* smem) {
  char* ws = p.ws;
  int rot = 0;
  tr_job(p.ab_w_in, (u16*)(ws + OFF_W1T), 1024, 1952, 2048, nullptr, rot, smem);
  tr_job(p.ssd_w_in, (u16*)(ws + OFF_W2T), 1024, 5152, 5376, nullptr, rot, smem);
  tr_job(p.ab_w_out, (u16*)(ws + OFF_WOT), 1024, 1024, 1024, nullptr, rot, smem);
  tr_job(p.ssd_w_out, (u16*)(ws + OFF_W3T), 2048, 1024, 1024, p.ssd_norm, rot, smem);
  tr_job(p.w_uq, (u16*)(ws + OFF_WQT), 256, 768, 768, p.qn, rot, smem);
  tr_job(p.w_ukv, (u16*)(ws + OFF_WKVT), 128, 1024, 1024, p.kvn, rot, smem);
  for (int hd = 0; hd < 8; ++hd) {
    tr_job(p.ga_w + hd * 4096, (u16*)(ws + OFF_WAT) + hd * 4096, 64, 64, 64, nullptr, rot, smem);
    tr_job(p.gx_w + hd * 4096, (u16*)(ws + OFF_WXT) + hd * 4096, 64, 64, 64, nullptr, rot, smem);
  }
  const size_t gid = (size_t)blockIdx.x * NT + tid_(), gstride = (size_t)gridDim.x * NT;
  {
    const f32x4* xs = (const f32x4*)p.x; u32x4* xb = (u32x4*)(ws + OFF_XB);
    const size_t n8 = (size_t)T * 1024 / 8;
    for (size_t i = gid; i < n8; i += gstride) {
      const f32x4 a = xs[2 * i], b = xs[2 * i + 1];
      u32x4 o; o.x = pk2(a.x, a.y); o.y = pk2(a.z, a.w); o.z = pk2(b.x, b.y); o.w = pk2(b.z, b.w);
      xb[i] = o;
    }
  }
  {
    float* ct = (float*)(ws + OFF_COS); float* st = (float*)(ws + OFF_SIN);
    for (size_t i = gid; i < (size_t)T * 16; i += gstride) {
      const int t = (int)(i >> 4), j = (int)(i & 15);
      const float inv = exp2f(-(float)j * (13.287712379549449f / 16.0f));
      const float ang = (float)p.pos[t] * inv;
      const double rev = (double)ang * 0.15915494309189535;
      const double fr = rev - rint(rev);
      const float a = (float)(fr * 6.283185307179586);
      ct[i] = cosf(a); st[i] = sinf(a);
    }
  }
  { float* sp = (float*)(ws + OFF_SP); for (size_t i = gid; i < 512; i += gstride) sp[i] = log1pf(expf(-p.lam[i])); }
  {
    float* ss = (float*)(ws + OFF_SS);
    for (size_t i = gid; i < (size_t)T * 4; i += gstride) ss[i] = 0.f;
  }
}

constexpr int GA_ST = 72;
constexpr float QSCALE = 0.10206207261596575f * 1.44269504088896341f;

template <int MODE>
DI void gemm_epi(const Params& p, int row, int colbase, int h, const f32x16& v, float rs) {
  char* ws = p.ws;
  if constexpr (MODE == 1) {
    u16* dst = (u16*)(ws + OFF_PROJ0) + (size_t)row * LD0;
#pragma unroll
    for (int g = 0; g < 4; ++g) {
      const int col = colbase + 8 * g + 4 * h;
      float a = v[4 * g], b = v[4 * g + 1], c = v[4 * g + 2], d = v[4 * g + 3];
      if (col >= 512 && col < 1536) { a = siluf_(a); b = siluf_(b); c = siluf_(c); d = siluf_(d); }
      u32x2 o; o.x = pk2(a, b); o.y = pk2(c, d);
      *(u32x2*)(dst + col) = o;
    }
  } else if constexpr (MODE == 2) {
    u16* dst = (u16*)(ws + OFF_Q) + (size_t)row * 768;
    f32x16 o;
    if ((colbase % 96) == 64) {
      const float* ct = (const float*)(ws + OFF_COS) + (size_t)row * 16;
      const float* st = (const float*)(ws + OFF_SIN) + (size_t)row * 16;
#pragma unroll
      for (int i = 0; i < 8; ++i) {
        const int idx = crow(i, h);
        const float c = ct[idx], s = st[idx], x1 = v[i] * rs, x2 = v[i + 8] * rs;
        o[i] = (x1 * c - x2 * s) * QSCALE; o[i + 8] = (x2 * c + x1 * s) * QSCALE;
      }
    } else {
#pragma unroll
      for (int i = 0; i < 16; ++i) o[i] = v[i] * (rs * QSCALE);
    }
#pragma unroll
    for (int g = 0; g < 4; ++g) {
      u32x2 w; w.x = pk2(o[4 * g], o[4 * g + 1]); w.y = pk2(o[4 * g + 2], o[4 * g + 3]);
      *(u32x2*)(dst + colbase + 8 * g + 4 * h) = w;
    }
  } else if constexpr (MODE == 3) {
    const int hd = colbase >> 7, within = colbase & 127;
    if (within < 64) {
      u16* dst = (u16*)(ws + OFF_KC) + (size_t)row * 768 + hd * 96 + within;
#pragma unroll
      for (int g = 0; g < 4; ++g) {
        u32x2 w; w.x = pk2(v[4 * g] * rs, v[4 * g + 1] * rs); w.y = pk2(v[4 * g + 2] * rs, v[4 * g + 3] * rs);
        *(u32x2*)(dst + 8 * g + 4 * h) = w;
      }
    } else {
      const int b = row >> 12, s = row & 4095;
      u16* dst = (u16*)(ws + OFF_VT) + ((size_t)(b * 8 + hd) * 64 + (within - 64)) * SEQ + s;
#pragma unroll
      for (int i = 0; i < 16; ++i) dst[(size_t)crow(i, h) * SEQ] = f2bf(v[i] * rs);
    }
  } else if constexpr (MODE == 4 || MODE == 6) {
    const float* src = (MODE == 4) ? p.x : p.out;
#pragma unroll
    for (int g = 0; g < 4; ++g) {
      const size_t off = (size_t)row * 1024 + colbase + 8 * g + 4 * h;
      const f32x4 xv = *(const f32x4*)(src + off);
      f32x4 o; o.x = DN_ALPHA * xv.x + v[4 * g]; o.y = DN_ALPHA * xv.y + v[4 * g + 1]; o.z = DN_ALPHA * xv.z + v[4 * g + 2]; o.w = DN_ALPHA * xv.w + v[4 * g + 3];
      *(f32x4*)(p.out + off) = o;
    }
  } else if constexpr (MODE == 5) {
    if (colbase < 5120) {
      u16* dst = (u16*)(ws + OFF_PROJ1) + (size_t)row * LD1;
#pragma unroll
      for (int g = 0; g < 4; ++g) {
        const int col = colbase + 8 * g + 4 * h;
        float a = v[4 * g], b = v[4 * g + 1], c = v[4 * g + 2], d = v[4 * g + 3];
        if (col < 2048) { a = siluf_(a); b = siluf_(b); c = siluf_(c); d = siluf_(d); }
        u32x2 o; o.x = pk2(a, b); o.y = pk2(c, d);
        *(u32x2*)(dst + col) = o;
      }
    } else if (colbase == 5120) {
      float* dst = (float*)(ws + OFF_DT) + (size_t)row * 32;
#pragma unroll
      for (int i = 0; i < 16; ++i) {
        const int c = crow(i, h);
        const float xv = v[i] + p.dt_bias[c];
        dst[c] = fmaxf(xv, 0.f) + log1pf(expf(-fabsf(xv)));
      }
    }
  }
}

template <int MODE>
DI void gemm_tile(const Params& p, const u16* __restrict__ A, int lda, const u16* __restrict__ Bt, int K, int m0, int n0, char* smem) {
  constexpr bool ROWNORM = (MODE == 2 || MODE == 3);
  constexpr bool GROUPS = (MODE == 6);
  u16* As = (u16*)smem;
  u16* Bs = (u16*)(smem + 2 * 256 * GA_ST * 2);
  float* ssrow = (float*)(smem + 2 * 256 * GA_ST * 2 + 2 * 128 * GA_ST * 2);
  const int tid = tid_(), lane = tid & 63, w = tid >> 6, wm = w & 3, wn = w >> 2, r = lane & 31, h = lane >> 5;
  const int lrow = tid >> 3, lkc = (tid & 7) * 8;
  const u16* ag = A + (size_t)(m0 + lrow) * lda + lkc;
  const u16* bg = Bt + (size_t)(n0 + lrow) * K + lkc;
  u32x4 ra[4], rb[2];
  float ssq[4] = {0.f, 0.f, 0.f, 0.f};
  f32x16 acc[2][2];
#pragma unroll
  for (int i = 0; i < 2; ++i)
#pragma unroll
    for (int j = 0; j < 2; ++j)
#pragma unroll
      for (int e = 0; e < 16; ++e) acc[i][j][e] = 0.f;
  const int nk = K / 64;
  auto gload = [&](int kt) {
#pragma unroll
    for (int i = 0; i < 4; ++i) ra[i] = *(const u32x4*)(ag + (size_t)(64 * i) * lda + kt * 64);
#pragma unroll
    for (int i = 0; i < 2; ++i) rb[i] = *(const u32x4*)(bg + (size_t)(64 * i) * K + kt * 64);
  };
  auto lstore = [&](int buf) {
    u16* as = As + buf * 256 * GA_ST; u16* bs = Bs + buf * 128 * GA_ST;
#pragma unroll
    for (int i = 0; i < 4; ++i) {
      *(u32x4*)(as + (lrow + 64 * i) * GA_ST + lkc) = ra[i];
      if constexpr (ROWNORM) { float f[8]; unpack8(ra[i], f);
#pragma unroll
        for (int e = 0; e < 8; ++e) ssq[i] += f[e] * f[e]; }
    }
#pragma unroll
    for (int i = 0; i < 2; ++i) *(u32x4*)(bs + (lrow + 64 * i) * GA_ST + lkc) = rb[i];
  };
  gload(0); lstore(0);
  __syncthreads();
  for (int kt = 0; kt < nk; ++kt) {
    const int buf = kt & 1;
    if (kt + 1 < nk) gload(kt + 1);
    const u16* as = As + buf * 256 * GA_ST + (wm * 64 + r) * GA_ST + h * 8;
    const u16* bs = Bs + buf * 128 * GA_ST + (wn * 64 + r) * GA_ST + h * 8;
#pragma unroll
    for (int ks = 0; ks < 4; ++ks) {
      const bf16x8 a0 = ld_frag16(as + ks * 16), a1 = ld_frag16(as + 32 * GA_ST + ks * 16);
      const bf16x8 b0 = ld_frag16(bs + ks * 16), b1 = ld_frag16(bs + 32 * GA_ST + ks * 16);
      acc[0][0] = MFMA32(b0, a0, acc[0][0]); acc[0][1] = MFMA32(b1, a0, acc[0][1]);
      acc[1][0] = MFMA32(b0, a1, acc[1][0]); acc[1][1] = MFMA32(b1, a1, acc[1][1]);
    }
    if constexpr (GROUPS) {
      if ((kt & 7) == 7) {
        const int g = kt >> 3;
        const float* ss = (const float*)(p.ws + OFF_SS);
#pragma unroll
        for (int mi = 0; mi < 2; ++mi) {
          const int row = m0 + wm * 64 + mi * 32 + r;
          const float sg = rsqrtf(ss[(size_t)row * 4 + g] * (1.0f / 512.0f) + 1e-6f);
          float sc = sg;
          if (g < 3) sc = sg * sqrtf(ss[(size_t)row * 4 + g + 1] * (1.0f / 512.0f) + 1e-6f);
#pragma unroll
          for (int ni = 0; ni < 2; ++ni)
#pragma unroll
            for (int e = 0; e < 16; ++e) acc[mi][ni][e] *= sc;
        }
      }
    }
    if (kt + 1 < nk) lstore(buf ^ 1);
    __syncthreads();
  }
  float rsv[2] = {1.f, 1.f};
  if constexpr (ROWNORM) {
#pragma unroll
    for (int i = 0; i < 4; ++i) {
      float s = ssq[i];
      s += __shfl_xor(s, 1); s += __shfl_xor(s, 2); s += __shfl_xor(s, 4);
      if ((tid & 7) == 0) ssrow[lrow + 64 * i] = s;
    }
    __syncthreads();
#pragma unroll
    for (int mi = 0; mi < 2; ++mi) rsv[mi] = rsqrtf(ssrow[wm * 64 + mi * 32 + r] / (float)K + 1e-6f);
  }
#pragma unroll
  for (int mi = 0; mi < 2; ++mi)
#pragma unroll
    for (int ni = 0; ni < 2; ++ni) {
      const int row = m0 + wm * 64 + mi * 32 + r, colbase = n0 + wn * 64 + ni * 32;
      gemm_epi<MODE>(p, row, colbase, h, acc[mi][ni], rsv[mi]);
    }
  __syncthreads();
}

template <int MODE>
DI void gemm_phase(const Params& p, const u16* A, int lda, const u16* Bt, int K, int Npad, int& rot, char* smem) {
  const int nN = Npad / 128, n = (T / 256) * nN, nb = gridDim.x;
  for (int it = (blockIdx.x + nb - rot) % nb; it < n; it += nb) gemm_tile<MODE>(p, A, lda, Bt, K, (it / nN) * 256, (it % nN) * 128, smem);
  rot = (rot + n) % nb;
}

namespace pg8 {
#define PG8_LAS __attribute__((address_space(3)))
typedef unsigned short bf16_t;
typedef short bf16x8 __attribute__((ext_vector_type(8)));
typedef float f32x4 __attribute__((ext_vector_type(4)));
typedef unsigned u32x4 __attribute__((ext_vector_type(4)));
constexpr int BM = 256, BK = 64, HALF = 128, HTB = HALF * BK * 2  , STAGE_BYTES = 8 * HTB, NXCD = 8, WGM = 8;

__host__ __device__ __forceinline__ int lds_byte(int r, int c) { const int st = (r >> 4) * 2 + (c >> 5), rr = r & 15, cc = c & 31, ob = rr * 64 + cc * 2; return st * 1024 + (ob ^ (((ob >> 9) & 1) << 5)); }
__host__ __device__ __forceinline__ void stage_rc(int b, int& R, int& C) { const int st = b / 1024, sb = b % 1024, swz = sb ^ (((sb >> 9) & 1) << 5); R = (st >> 1) * 16 + swz / 64; C = (st & 1) * 32 + (swz % 64) / 2; }
__host__ __device__ __forceinline__ int perm32(int rho) { const int n = rho >> 4, i = rho & 15; return 8 * (i >> 2) + 4 * n + (i & 3); }

struct Unit { int pm, pn; };
struct Gemm { const bf16_t* A; const bf16_t* Bt; int M, N, K, lda; };

struct StaticOrder {
    int nM, nN, nwg, G, c;
    __host__ __device__ void init(int M, int N, int G_, int c_) { nM = M / BM; nN = N / BM; nwg = nM * nN; G = G_; c = c_; }
    __host__ __device__ bool next(int i, Unit& u) const {
        const long L = (long)i * G + c; if (L >= nwg) return false;
        int wgid = (int)L; { const int q = nwg / NXCD, r = nwg % NXCD, xcd = wgid % NXCD, off = wgid / NXCD; wgid = (xcd < r ? xcd * (q + 1) : r * (q + 1) + (xcd - r) * q) + off; }
        const int nig = WGM * nN, gid = wgid / nig, fm = gid * WGM, gsz = (nM - fm) < WGM ? (nM - fm) : WGM;
        u.pm = fm + ((wgid % nig) % gsz); u.pn = (wgid % nig) / gsz; return true;
    }
    __device__ __forceinline__ void a_ready(const Unit&) const {}
    __device__ __forceinline__ void done(const Unit&) const {}
};
template <class Epi, class Sched, bool STAMP = false>
__device__ __forceinline__ void gemm_phase(PG8_LAS unsigned char* lds, const Gemm g, const Sched& S, const Epi& E, unsigned long long* stamps) {
    const int tid = tid_(), wid = __builtin_amdgcn_readfirstlane(tid >> 6), lane = tid & 63, wr = wid >> 2, wc = wid & 3, fr = lane & 15, fq = lane >> 4;
    const int K = g.K, nt = K / BK;
    int ts_lo = 0, ts_hi = 0, nts = 0; const unsigned long long rt_entry = STAMP ? (unsigned long long)wall_clock64() : 0ull;
#define PG8_STAMP() do { if (STAMP && wid == 0 && nts < 64) { const unsigned long long _c = (unsigned long long)clock64(); \
        ts_lo = (lane == nts) ? (int)(unsigned)_c : ts_lo; ts_hi = (lane == nts) ? (int)(unsigned)(_c >> 32) : ts_hi; ++nts; } } while (0)
    PG8_STAMP();
    unsigned voffA[2], voffB[2];
#pragma unroll
    for (int i = 0; i < 2; ++i) { int R, C; stage_rc(tid * 16 + i * 8192, R, C); const int Rb = Epi::PERM ? ((R & ~31) + perm32(R & 31)) : R;
        voffA[i] = (unsigned)(R * g.lda + C) * 2u; voffB[i] = (unsigned)(Rb * K + C) * 2u; }
    const size_t kstep = (size_t)(BK * 2);
    const size_t hstepA = (size_t)HALF * g.lda * 2, hstepB = (size_t)HALF * K * 2;
    const size_t tstepA = 2 * hstepA, tstepB = 2 * hstepB;
    const unsigned ldsw = (unsigned)wid * 1024u;
    const int aoff = lds_byte(wr * 64 + fr, fq * 8), boff = lds_byte(wc * 32 + fr, fq * 8);
#define PG8_SA(b, h) (((b) * 2 + (h)) * HTB)
#define PG8_SB(b, h) ((4 + (b) * 2 + (h)) * HTB)
#define PG8_STAGE(bufoff, gbase, voff) do { _Pragma("unroll") for (int _i = 0; _i < 2; ++_i) \
        __builtin_amdgcn_global_load_lds((const unsigned*)((const char*)(gbase) + (voff)[_i]), (PG8_LAS unsigned*)(lds + (bufoff) + ldsw + _i * 8192), 16, 0, 0); } while (0)
#define PG8_LDA(dst, b, h) do { _Pragma("unroll") for (int m = 0; m < 4; ++m) _Pragma("unroll") for (int k = 0; k < 2; ++k) dst[m][k] = *(const PG8_LAS bf16x8*)(lds + PG8_SA(b, h) + aoff + m * 2048 + k * 1024); } while (0)
#define PG8_LDB(dst, b, h) do { _Pragma("unroll") for (int n = 0; n < 2; ++n) _Pragma("unroll") for (int k = 0; k < 2; ++k) dst[n][k] = *(const PG8_LAS bf16x8*)(lds + PG8_SB(b, h) + boff + n * 2048 + k * 1024); } while (0)
#define PG8_MMA(ai, bj, At, Bt) do { __builtin_amdgcn_s_setprio(1); _Pragma("unroll") for (int m = 0; m < 4; ++m) _Pragma("unroll") for (int n = 0; n < 2; ++n) _Pragma("unroll") for (int k = 0; k < 2; ++k) \
        acc[ai][bj][m][n] = __builtin_amdgcn_mfma_f32_16x16x32_bf16(Bt[n][k], At[m][k], acc[ai][bj][m][n], 0, 0, 0); __builtin_amdgcn_s_setprio(0); } while (0)
#define PG8_WAIT_V(n) asm volatile("s_waitcnt vmcnt(" #n ")" ::: "memory")
#define PG8_WAIT_L(n) asm volatile("s_waitcnt lgkmcnt(" #n ")" ::: "memory")
#define PG8_BAR __builtin_amdgcn_s_barrier()
#define PG8_SCHED __builtin_amdgcn_sched_barrier(0)
    Unit cur, nxt; int ui = 0;
    if (!S.next(0, cur)) return;
    f32x4 acc[2][2][4][2];
#pragma unroll
    for (int a = 0; a < 2; ++a)
#pragma unroll
        for (int b = 0; b < 2; ++b)
#pragma unroll
            for (int m = 0; m < 4; ++m)
#pragma unroll
                for (int n = 0; n < 2; ++n) acc[a][b][m][n] = (f32x4){0.f, 0.f, 0.f, 0.f};
    bf16x8 At[4][2], B0[2][2], B1[2][2];
    const char* cA = (const char*)g.A + (size_t)cur.pm * tstepA; const char* cB = (const char*)g.Bt + (size_t)cur.pn * tstepB;
    S.a_ready(cur);
    PG8_STAGE(PG8_SB(0, 0), cB, voffB); PG8_STAGE(PG8_SA(0, 0), cA, voffA); PG8_STAGE(PG8_SB(0, 1), cB + hstepB, voffB); PG8_STAGE(PG8_SA(0, 1), cA + hstepA, voffA);
    if (wr == 1) PG8_BAR;
    PG8_WAIT_V(4); PG8_BAR;
    PG8_STAGE(PG8_SB(1, 0), cB + kstep, voffB); PG8_STAGE(PG8_SA(1, 0), cA + kstep, voffA); PG8_STAGE(PG8_SB(1, 1), cB + hstepB + kstep, voffB);
    PG8_WAIT_V(6); PG8_BAR;
    PG8_STAMP();
    for (;;) {
        const bool has_next = S.next(ui + 1, nxt);
        const char* nA = has_next ? (const char*)g.A + (size_t)nxt.pm * tstepA : cA; const char* nB = has_next ? (const char*)g.Bt + (size_t)nxt.pn * tstepB : cB;
        for (int t = 0; t < nt; t += 2) {
            const bool last = (t == nt - 2);
            const char* a1 = cA + (size_t)(t + 1) * kstep;
            const char* a2 = last ? nA : cA + (size_t)(t + 2) * kstep; const char* b2 = last ? nB : cB + (size_t)(t + 2) * kstep;
            const char* a3 = a2 + kstep; const char* b3 = b2 + kstep;
            if (last && has_next) S.a_ready(nxt);
            PG8_LDB(B0, 0, 0); PG8_SCHED; PG8_LDA(At, 0, 0); PG8_STAGE(PG8_SA(1, 1), a1 + hstepA, voffA);
            PG8_WAIT_L(8); PG8_BAR; PG8_WAIT_L(0); PG8_MMA(0, 0, At, B0); PG8_BAR; PG8_SCHED;
            PG8_LDB(B1, 0, 1); PG8_STAGE(PG8_SB(0, 0), b2, voffB);
            PG8_BAR; PG8_WAIT_L(0); PG8_MMA(0, 1, At, B1); PG8_BAR;
            PG8_LDA(At, 0, 1); PG8_STAGE(PG8_SA(0, 0), a2, voffA);
            PG8_BAR; PG8_WAIT_L(0); PG8_MMA(1, 0, At, B0); PG8_BAR; PG8_SCHED;
            PG8_STAGE(PG8_SB(0, 1), b2 + hstepB, voffB);
            PG8_WAIT_V(6); PG8_BAR; PG8_MMA(1, 1, At, B1); PG8_BAR;
            PG8_LDB(B0, 1, 0); PG8_SCHED; PG8_LDA(At, 1, 0); PG8_STAGE(PG8_SA(0, 1), a2 + hstepA, voffA);
            PG8_WAIT_L(8); PG8_BAR; PG8_WAIT_L(0); PG8_MMA(0, 0, At, B0); PG8_BAR; PG8_SCHED;
            PG8_LDB(B1, 1, 1); PG8_STAGE(PG8_SB(1, 0), b3, voffB);
            PG8_BAR; PG8_WAIT_L(0); PG8_MMA(0, 1, At, B1); PG8_BAR;
            PG8_LDA(At, 1, 1); PG8_STAGE(PG8_SA(1, 0), a3, voffA);
            PG8_BAR; PG8_WAIT_L(0); PG8_MMA(1, 0, At, B0); PG8_BAR; PG8_SCHED;
            PG8_STAGE(PG8_SB(1, 1), b3 + hstepB, voffB);
            PG8_WAIT_V(6); PG8_BAR; PG8_MMA(1, 1, At, B1); PG8_BAR;
            if constexpr (Epi::KHOOK) { if (((t + 2) & 7) == 0) E.khook(acc, cur, ((t + 2) >> 3) - 1, wr, wc, fr, fq); }
        }
        PG8_STAMP();
        if constexpr (!Epi::AFTER_DRAIN) { E(acc, cur, wr, wc, fr, fq); S.done(cur); }
        PG8_STAMP();
        if (!has_next) break;
#pragma unroll
        for (int a = 0; a < 2; ++a)
#pragma unroll
            for (int b = 0; b < 2; ++b)
#pragma unroll
                for (int m = 0; m < 4; ++m)
#pragma unroll
                    for (int n = 0; n < 2; ++n) acc[a][b][m][n] = (f32x4){0.f, 0.f, 0.f, 0.f};
        cur = nxt; cA = nA; cB = nB; ++ui;
    }
    PG8_WAIT_V(0);
    if (wr == 0) PG8_BAR;
    PG8_BAR;
    if constexpr (Epi::AFTER_DRAIN) { E.fused(acc, cur, wr, wc, fr, fq, lds, wid, lane); S.done(cur); }
    PG8_STAMP();
    if (STAMP && wid == 0) { stamps[lane] = lane < nts ? (((unsigned long long)(unsigned)ts_hi << 32) | (unsigned)ts_lo) : 0ull;
        if (lane == 62) stamps[62] = rt_entry; if (lane == 63) stamps[63] = (unsigned long long)wall_clock64(); }
#undef PG8_STAMP
#undef PG8_SA
#undef PG8_SB
#undef PG8_STAGE
#undef PG8_LDA
#undef PG8_LDB
#undef PG8_MMA
#undef PG8_WAIT_V
#undef PG8_WAIT_L
#undef PG8_BAR
#undef PG8_SCHED
}
}

struct EpiProj0 {
  static constexpr bool PERM = true, AFTER_DRAIN = false, KHOOK = false;
  u16* O;
  DI void operator()(const f32x4 (&acc)[2][2][4][2], const pg8::Unit& u, int wr, int wc, int fr, int fq) const {
    const int row0 = u.pm * 256 + wr * 64 + fr;
#pragma unroll
    for (int ai = 0; ai < 2; ++ai)
#pragma unroll
      for (int m = 0; m < 4; ++m) {
        u16* rowp = O + (size_t)(row0 + ai * 128 + m * 16) * LD0;
#pragma unroll
        for (int bj = 0; bj < 2; ++bj) {
          const int colb = u.pn * 256 + bj * 128;
          f32x4 v0 = acc[ai][bj][m][0], v1 = acc[ai][bj][m][1];
          if (colb >= 512 && colb < 1536) {
#pragma unroll
            for (int e = 0; e < 4; ++e) { v0[e] = siluf_(v0[e]); v1[e] = siluf_(v1[e]); }
          }
          u32x4 w; w.x = pk2(v0[0], v0[1]); w.y = pk2(v0[2], v0[3]); w.z = pk2(v1[0], v1[1]); w.w = pk2(v1[2], v1[3]);
          *(u32x4*)(rowp + colb + wc * 32 + 8 * fq) = w;
        }
      }
  }
};
struct EpiProj1 {
  static constexpr bool PERM = true, AFTER_DRAIN = false, KHOOK = false;
  u16* Z; u16* X; u16* H; float* dt;
  DI void operator()(const f32x4 (&acc)[2][2][4][2], const pg8::Unit& u, int wr, int wc, int fr, int fq) const {
    const int row0 = u.pm * 256 + wr * 64 + fr;
#pragma unroll
    for (int ai = 0; ai < 2; ++ai)
#pragma unroll
      for (int m = 0; m < 4; ++m) {
        const int row = row0 + ai * 128 + m * 16;
#pragma unroll
        for (int bj = 0; bj < 2; ++bj) {
          const int colb = u.pn * 256 + bj * 128, col = colb + wc * 32 + 8 * fq;
          f32x4 v0 = acc[ai][bj][m][0], v1 = acc[ai][bj][m][1];
          if (colb < 2048) {
#pragma unroll
            for (int e = 0; e < 4; ++e) { v0[e] = siluf_(v0[e]); v1[e] = siluf_(v1[e]); }
            u32x4 w; w.x = pk2(v0[0], v0[1]); w.y = pk2(v0[2], v0[3]); w.z = pk2(v1[0], v1[1]); w.w = pk2(v1[2], v1[3]);
            *(u32x4*)(Z + (size_t)row * 2048 + col) = w;
          } else if (colb < 5120) {
            u32x4 w; w.x = pk2(v0[0], v0[1]); w.y = pk2(v0[2], v0[3]); w.z = pk2(v1[0], v1[1]); w.w = pk2(v1[2], v1[3]);
            *(u32x4*)(X + (size_t)row * 3072 + (col - 2048)) = w;
            if ((row & 63) >= 61) *(u32x4*)(H + ((size_t)(row >> 6) * 3 + ((row & 63) - 61)) * 3072 + (col - 2048)) = w;
          } else if (colb == 5120 && wc == 0) {
            *(f32x4*)(dt + (size_t)row * 32 + 8 * fq) = v0; *(f32x4*)(dt + (size_t)row * 32 + 8 * fq + 4) = v1;
          }
        }
      }
  }
};
template <bool HOOK> struct EpiResid {
  static constexpr bool PERM = false, AFTER_DRAIN = false, KHOOK = HOOK;
  const float* src; float* dst; const float* ss;
  DI void khook(f32x4 (&acc)[2][2][4][2], const pg8::Unit& u, int g, int wr, int wc, int fr, int fq) const {
    const int row0 = u.pm * 256 + wr * 64 + fr;
    float sc[2][4];
#pragma unroll
    for (int ai = 0; ai < 2; ++ai)
#pragma unroll
      for (int m = 0; m < 4; ++m) {
        const float* sp = ss + (size_t)(row0 + ai * 128 + m * 16) * 4;
        const float a = sp[g], b = sp[(g < 3) ? g + 1 : g];
        float s = rsqrtf(a * (1.0f / 512.0f) + 1e-6f);
        if (g < 3) s *= sqrtf(b * (1.0f / 512.0f) + 1e-6f);
        sc[ai][m] = s;
      }
    asm volatile("s_waitcnt vmcnt(0)" ::: "memory");
#pragma unroll
    for (int ai = 0; ai < 2; ++ai)
#pragma unroll
      for (int m = 0; m < 4; ++m)
#pragma unroll
        for (int bj = 0; bj < 2; ++bj)
#pragma unroll
          for (int n = 0; n < 2; ++n) acc[ai][bj][m][n] *= sc[ai][m];
  }
  DI void operator()(const f32x4 (&acc)[2][2][4][2], const pg8::Unit& u, int wr, int wc, int fr, int fq) const {
    const int row0 = u.pm * 256 + wr * 64 + fr, col0 = u.pn * 256 + wc * 32 + 4 * fq;
#pragma unroll
    for (int ai = 0; ai < 2; ++ai)
#pragma unroll
      for (int m = 0; m < 4; ++m) {
        const size_t ro = (size_t)(row0 + ai * 128 + m * 16) * 1024 + col0;
#pragma unroll
        for (int bj = 0; bj < 2; ++bj)
#pragma unroll
          for (int n = 0; n < 2; ++n) {
            const f32x4 xv = *(const f32x4*)(src + ro + bj * 128 + n * 16);
            *(f32x4*)(dst + ro + bj * 128 + n * 16) = xv * DN_ALPHA + acc[ai][bj][m][n];
          }
      }
  }
};
template <class Epi>
DI void pg8_run(const u16* A, int lda, const u16* Bt, int N, int K, const Epi& E, char* smem) {
  pg8::Gemm g; g.A = A; g.Bt = Bt; g.M = T; g.N = N; g.K = K; g.lda = lda;
  pg8::StaticOrder S; S.init(T, N, (int)gridDim.x, (int)blockIdx.x);
  pg8::gemm_phase<Epi, pg8::StaticOrder, false>((PG8_LAS unsigned char*)smem, g, S, E, nullptr);
  __syncthreads();
}

DI float neg_expm1(float x) {
  if (x > -0.1f) return -x * (1.0f + x * (0.5f + x * ((1.0f / 6.0f) + x * ((1.0f / 24.0f) + x * (1.0f / 120.0f)))));
  return 1.0f - fast_exp(x);
}
DI void rglru_item(const Params& p, int item, char* smem) {
  char* ws = p.ws;
  const int hd = item & 7, bc = item >> 3, c = bc & 31, b = bc >> 5;
  const int t0 = b * SEQ + c * 128, s0 = c * 128;
  u16* Xc = (u16*)smem;
  u16* Was = (u16*)(smem + 18432);
  u16* Wxs = (u16*)(smem + 18432 + 9216);
  float* Xf = (float*)(smem + 36864);
  float* tend = (float*)(smem + 36864 + 33280);
  const int tid = tid_(), lane = tid & 63, w = tid >> 6, r = lane & 31, h = lane >> 5;
  const u16* proj0 = (const u16*)(ws + OFF_PROJ0);
  {
    const int cc = (tid & 7) * 8, ch = hd * 64 + cc;
    float cw[4][8], cb[8];
#pragma unroll
    for (int k = 0; k < 4; ++k)
#pragma unroll
      for (int e = 0; e < 8; ++e) cw[k][e] = p.ab_conv_w[k * 512 + ch + e];
#pragma unroll
    for (int e = 0; e < 8; ++e) cb[e] = p.ab_conv_b[ch + e];
#pragma unroll
    for (int i = 0; i < 2; ++i) {
      const int l = (tid >> 3) + 64 * i;
      float xc[8];
#pragma unroll
      for (int e = 0; e < 8; ++e) xc[e] = cb[e];
#pragma unroll
      for (int k = 0; k < 4; ++k) {
        const int s = s0 + l - 3 + k;
        if (s >= 0) {
          const u32x4 v = *(const u32x4*)(proj0 + (size_t)(t0 + l - 3 + k) * LD0 + ch);
          float f[8]; unpack8(v, f);
#pragma unroll
          for (int e = 0; e < 8; ++e) xc[e] += cw[k][e] * f[e];
        }
      }
      *(u32x4*)(Xc + l * GA_ST + cc) = pack8(xc);
#pragma unroll
      for (int e = 0; e < 8; ++e) Xf[l * 65 + cc + e] = xc[e];
    }
    const int j = tid >> 3;
    *(u32x4*)(Was + j * GA_ST + cc) = *(const u32x4*)((const u16*)(ws + OFF_WAT) + hd * 4096 + j * 64 + cc);
    *(u32x4*)(Wxs + j * GA_ST + cc) = *(const u32x4*)((const u16*)(ws + OFF_WXT) + hd * 4096 + j * 64 + cc);
  }
  __syncthreads();
  const int lt = w & 3, jt = w >> 2;
  f32x16 accA, accX;
#pragma unroll
  for (int e = 0; e < 16; ++e) { accA[e] = 0.f; accX[e] = 0.f; }
#pragma unroll
  for (int ks = 0; ks < 4; ++ks) {
    const bf16x8 af = ld_frag16(Xc + (lt * 32 + r) * GA_ST + ks * 16 + h * 8);
    const bf16x8 ba = ld_frag16(Was + (jt * 32 + r) * GA_ST + ks * 16 + h * 8);
    const bf16x8 bx = ld_frag16(Wxs + (jt * 32 + r) * GA_ST + ks * 16 + h * 8);
    accA = MFMA32(ba, af, accA); accX = MFMA32(bx, af, accX);
  }
  float Av[16], Bv[16];
#pragma unroll
  for (int i = 0; i < 16; ++i) {
    const int j = jt * 32 + crow(i, h), chg = hd * 64 + j;
    const float ra_ = sigmoidf_(accA[i] + p.ga_b[chg]);
    const float ix = sigmoidf_(accX[i] + p.gx_b[chg]);
    const float sp = ((const float*)(ws + OFF_SP))[chg];
    const float log_a = -8.0f * ra_ * sp;
    Av[i] = fast_exp(log_a);
    const float mult = sqrtf(neg_expm1(2.0f * log_a));
    Bv[i] = mult * ix * Xf[(lt * 32 + r) * 65 + j];
  }
#pragma unroll
  for (int d = 1; d < 32; d <<= 1) {
#pragma unroll
    for (int i = 0; i < 16; ++i) {
      const float Ap = __shfl_up(Av[i], d, 32), Bp = __shfl_up(Bv[i], d, 32);
      if (r >= d) { Bv[i] = Av[i] * Bp + Bv[i]; Av[i] = Av[i] * Ap; }
    }
  }
  if (r == 31) {
#pragma unroll
    for (int i = 0; i < 16; ++i) { const int j = jt * 32 + crow(i, h); tend[(lt * 64 + j) * 2] = Av[i]; tend[(lt * 64 + j) * 2 + 1] = Bv[i]; }
  }
  __syncthreads();
  const int t = t0 + lt * 32 + r;
  u16* hl = (u16*)(ws + OFF_HLOC) + (size_t)t * 512 + hd * 64;
  u16* pc = (u16*)(ws + OFF_PCUM) + (size_t)t * 512 + hd * 64;
  float hf[16], pf[16];
#pragma unroll
  for (int i = 0; i < 16; ++i) {
    const int j = jt * 32 + crow(i, h);
    float Hc = 0.f, Pp = 1.f;
    for (int tp = 0; tp < lt; ++tp) { const float Pe = tend[(tp * 64 + j) * 2], He = tend[(tp * 64 + j) * 2 + 1]; Hc = Pe * Hc + He; Pp *= Pe; }
    hf[i] = Bv[i] + Av[i] * Hc; pf[i] = Av[i] * Pp;
  }
#pragma unroll
  for (int g = 0; g < 4; ++g) {
    const int j = jt * 32 + 8 * g + 4 * h;
    u32x2 o; o.x = pk2(hf[4 * g], hf[4 * g + 1]); o.y = pk2(hf[4 * g + 2], hf[4 * g + 3]);
    *(u32x2*)(hl + j) = o;
    o.x = pk2(pf[4 * g], pf[4 * g + 1]); o.y = pk2(pf[4 * g + 2], pf[4 * g + 3]);
    *(u32x2*)(pc + j) = o;
  }
  if (lt == 3 && r == 31) {
    float* he = (float*)(ws + OFF_HEND) + (size_t)(b * 32 + c) * 512 + hd * 64;
    float* pe = (float*)(ws + OFF_PEND) + (size_t)(b * 32 + c) * 512 + hd * 64;
#pragma unroll
    for (int i = 0; i < 16; ++i) { const int j = jt * 32 + crow(i, h); he[j] = hf[i]; pe[j] = pf[i]; }
  }
  __syncthreads();
}

DI void krope_item(const Params& p, int item) {
  char* ws = p.ws;
  const u16* proj0 = (const u16*)(ws + OFF_PROJ0);
  const float* ct = (const float*)(ws + OFF_COS); const float* st = (const float*)(ws + OFF_SIN);
  u16* kc = (u16*)(ws + OFF_KC);
#pragma unroll
  for (int i = 0; i < 8; ++i) {
    const int u = tid_() + NT * i, tl = u >> 4, j = u & 15, t = item * 256 + tl;
    const float x1 = bf2f(proj0[(size_t)t * LD0 + 1920 + j]), x2 = bf2f(proj0[(size_t)t * LD0 + 1936 + j]);
    const float c = ct[(size_t)t * 16 + j], s = st[(size_t)t * 16 + j];
    const u16 o1 = f2bf(x1 * c - x2 * s), o2 = f2bf(x2 * c + x1 * s);
#pragma unroll
    for (int hh = 0; hh < 8; ++hh) { kc[(size_t)t * 768 + hh * 96 + 64 + j] = o1; kc[(size_t)t * 768 + hh * 96 + 80 + j] = o2; }
  }
}

constexpr int KS_ST = 104, VS_ST = 72;
DI void attn_item(const Params& p, int bh, int qb, char* smem) {
  char* ws = p.ws;
  const int b = bh >> 3, hh = bh & 7;
  u16* Ks = (u16*)smem;
  u16* Vs = (u16*)(smem + 2 * 64 * KS_ST * 2);
  const int tid = tid_(), lane = tid & 63, w = tid >> 6, r = lane & 31, h = lane >> 5;
  const int q0 = qb * 256, qw = q0 + w * 32, sq = qw + r;
  const size_t t = (size_t)b * SEQ + sq;
  const u16* Q = (const u16*)(ws + OFF_Q);
  const u16* Kc = (const u16*)(ws + OFF_KC) + (size_t)b * SEQ * 768 + hh * 96;
  const u16* Vt = (const u16*)(ws + OFF_VT) + (size_t)bh * 64 * SEQ;
  bf16x8 qf[6];
#pragma unroll
  for (int s = 0; s < 6; ++s) qf[s] = ld_frag16(Q + t * 768 + hh * 96 + s * 16 + h * 8);
  f32x16 o0, o1;
#pragma unroll
  for (int e = 0; e < 16; ++e) { o0[e] = 0.f; o1[e] = 0.f; }
  float m = -1e30f, l = 0.f;
  const int nkt = 4 * (qb + 1);
  const int c0 = tid, c1 = tid + NT;
  const int kr0 = c0 / 12, kc0 = (c0 % 12) * 8, kr1 = c1 / 12, kc1 = (c1 % 12) * 8;
  const bool has1 = c1 < 768;
  const int vd = tid >> 3, vk = (tid & 7) * 8;
  u32x4 rk0, rk1, rv;
  auto gload = [&](int kt) {
    const int k0 = kt * 64;
    rk0 = *(const u32x4*)(Kc + (size_t)(k0 + kr0) * 768 + kc0);
    if (has1) rk1 = *(const u32x4*)(Kc + (size_t)(k0 + kr1) * 768 + kc1);
    rv = *(const u32x4*)(Vt + (size_t)vd * SEQ + k0 + vk);
  };
  auto lstore = [&](int buf) {
    u16* ks = Ks + buf * 64 * KS_ST; u16* vs = Vs + buf * 64 * VS_ST;
    *(u32x4*)(ks + kr0 * KS_ST + kc0) = rk0;
    if (has1) *(u32x4*)(ks + kr1 * KS_ST + kc1) = rk1;
    *(u32x4*)(vs + vd * VS_ST + vk) = rv;
  };
  gload(0); lstore(0);
  __syncthreads();
  for (int kt = 0; kt < nkt; ++kt) {
    const int buf = kt & 1, k0 = kt * 64;
    if (kt + 1 < nkt) gload(kt + 1);
    if (k0 <= qw + 31) {
      const u16* ks = Ks + buf * 64 * KS_ST; const u16* vs = Vs + buf * 64 * VS_ST;
      f32x16 st0, st1;
#pragma unroll
      for (int e = 0; e < 16; ++e) { st0[e] = 0.f; st1[e] = 0.f; }
#pragma unroll
      for (int s = 0; s < 6; ++s) {
        const bf16x8 k0f = ld_frag16(ks + r * KS_ST + s * 16 + h * 8);
        const bf16x8 k1f = ld_frag16(ks + (32 + r) * KS_ST + s * 16 + h * 8);
        st0 = MFMA32(k0f, qf[s], st0); st1 = MFMA32(k1f, qf[s], st1);
      }
      if (k0 + 63 > qw) {
#pragma unroll
        for (int i = 0; i < 16; ++i) {
          const int key = k0 + crow(i, h);
          if (key > sq) st0[i] = -1e30f;
          if (key + 32 > sq) st1[i] = -1e30f;
        }
      }
      float mx = st0[0];
#pragma unroll
      for (int i = 1; i < 16; ++i) mx = fmaxf(mx, st0[i]);
#pragma unroll
      for (int i = 0; i < 16; ++i) mx = fmaxf(mx, st1[i]);
      mx = fmaxf(mx, __shfl_xor(mx, 32));
      const float mn = fmaxf(m, mx), alpha = fast_exp2(m - mn);
      float ls = 0.f;
#pragma unroll
      for (int i = 0; i < 16; ++i) { st0[i] = fast_exp2(st0[i] - mn); st1[i] = fast_exp2(st1[i] - mn); ls += st0[i] + st1[i]; }
      l = l * alpha + ls; m = mn;
#pragma unroll
      for (int e = 0; e < 16; ++e) { o0[e] *= alpha; o1[e] *= alpha; }
#pragma unroll
      for (int s = 0; s < 2; ++s) {
        const bf16x8 p0 = pack_frag(st0, s), p1 = pack_frag(st1, s);
        {
          const u16* v0 = vs + r * VS_ST + 16 * s + 4 * h;
          const bf16x8 va = ld_frag8x2(v0, v0 + 8), vb = ld_frag8x2(v0 + 32 * VS_ST, v0 + 32 * VS_ST + 8);
          o0 = MFMA32(va, p0, o0); o1 = MFMA32(vb, p0, o1);
        }
        {
          const u16* v1 = vs + r * VS_ST + 32 + 16 * s + 4 * h;
          const bf16x8 va = ld_frag8x2(v1, v1 + 8), vb = ld_frag8x2(v1 + 32 * VS_ST, v1 + 32 * VS_ST + 8);
          o0 = MFMA32(va, p1, o0); o1 = MFMA32(vb, p1, o1);
        }
      }
    }
    if (kt + 1 < nkt) lstore(buf ^ 1);
    __syncthreads();
  }
  const float lt = l + __shfl_xor(l, 32), inv = 1.0f / lt;
  const u16* sg = (const u16*)(ws + OFF_PROJ0) + t * LD0 + 1024 + hh * 64;
  u16* yc = (u16*)(ws + OFF_YCAT) + t * 1024 + 512 + hh * 64;
#pragma unroll
  for (int dt = 0; dt < 2; ++dt)
#pragma unroll
    for (int g = 0; g < 4; ++g) {
      const int d = dt * 32 + 8 * g + 4 * h;
      const u32x2 gv = *(const u32x2*)(sg + d);
      const f32x16& o = dt ? o1 : o0;
      u32x2 ov;
      ov.x = pk2(o[4 * g] * inv * bflo(gv.x), o[4 * g + 1] * inv * bfhi(gv.x));
      ov.y = pk2(o[4 * g + 2] * inv * bflo(gv.y), o[4 * g + 3] * inv * bfhi(gv.y));
      *(u32x2*)(yc + d) = ov;
    }
}

DI void fixup_item(const Params& p, int item, char* smem) {
  char* ws = p.ws;
  const int b = item >> 5, c = item & 31, tid = tid_();
  float* Hin = (float*)smem;
  {
    const float* he = (const float*)(ws + OFF_HEND) + (size_t)(b * 32) * 512 + tid;
    const float* pe = (const float*)(ws + OFF_PEND) + (size_t)(b * 32) * 512 + tid;
    float H = 0.f;
    int cp = 0;
    for (; cp + 8 <= c; cp += 8) {
      float pv[8], hv[8];
#pragma unroll
      for (int k = 0; k < 8; ++k) { pv[k] = pe[(cp + k) * 512]; hv[k] = he[(cp + k) * 512]; }
#pragma unroll
      for (int k = 0; k < 8; ++k) H = pv[k] * H + hv[k];
    }
    for (; cp < c; ++cp) H = pe[cp * 512] * H + he[cp * 512];
    Hin[tid] = H;
  }
  __syncthreads();
  const size_t t0 = (size_t)b * SEQ + c * 128;
  const u16* hl = (const u16*)(ws + OFF_HLOC); const u16* pc = (const u16*)(ws + OFF_PCUM);
  const u16* proj0 = (const u16*)(ws + OFF_PROJ0); u16* yc = (u16*)(ws + OFF_YCAT);
#pragma unroll 4
  for (int i = 0; i < 16; ++i) {
    const int u = tid + NT * i, l = u >> 6, cc = (u & 63) * 8;
    const size_t tt = t0 + l;
    const u32x4 hv = *(const u32x4*)(hl + tt * 512 + cc), pv = *(const u32x4*)(pc + tt * 512 + cc), gv = *(const u32x4*)(proj0 + tt * LD0 + 512 + cc);
    float hf[8], pf[8], gf[8], o[8];
    unpack8(hv, hf); unpack8(pv, pf); unpack8(gv, gf);
#pragma unroll
    for (int e = 0; e < 8; ++e) o[e] = (hf[e] + pf[e] * Hin[cc + e]) * gf[e];
    *(u32x4*)(yc + tt * 1024 + cc) = pack8(o);
  }
  __syncthreads();
}

DI void ln_phase(const Params& p, const float* __restrict__ g, const float* __restrict__ bta, u16* xb) {
  const int lane = tid_() & 63, gw = blockIdx.x * 8 + (tid_() >> 6), nw = gridDim.x * 8;
  f32x4 gg[4], bb[4];
#pragma unroll
  for (int i = 0; i < 4; ++i) { gg[i] = *(const f32x4*)(g + i * 256 + lane * 4); bb[i] = *(const f32x4*)(bta + i * 256 + lane * 4); }
  for (int row = gw; row < T; row += nw) {
    float* pr = p.out + (size_t)row * 1024;
    f32x4 v[4];
    float s = 0.f;
#pragma unroll
    for (int i = 0; i < 4; ++i) { v[i] = *(const f32x4*)(pr + i * 256 + lane * 4); s += (v[i].x + v[i].y) + (v[i].z + v[i].w); }
#pragma unroll
    for (int d = 1; d < 64; d <<= 1) s += __shfl_xor(s, d);
    const float mu = s * (1.0f / 1024.0f);
    float q = 0.f;
#pragma unroll
    for (int i = 0; i < 4; ++i) { v[i].x -= mu; v[i].y -= mu; v[i].z -= mu; v[i].w -= mu; q += (v[i].x * v[i].x + v[i].y * v[i].y) + (v[i].z * v[i].z + v[i].w * v[i].w); }
#pragma unroll
    for (int d = 1; d < 64; d <<= 1) q += __shfl_xor(q, d);
    const float rstd = rsqrtf(q * (1.0f / 1024.0f) + 1e-5f);
#pragma unroll
    for (int i = 0; i < 4; ++i) {
      f32x4 o;
      o.x = v[i].x * rstd * gg[i].x + bb[i].x; o.y = v[i].y * rstd * gg[i].y + bb[i].y; o.z = v[i].z * rstd * gg[i].z + bb[i].z; o.w = v[i].w * rstd * gg[i].w + bb[i].w;
      *(f32x4*)(pr + i * 256 + lane * 4) = o;
      if (xb) { u32x2 w; w.x = pk2(o.x, o.y); w.y = pk2(o.z, o.w); *(u32x2*)(xb + (size_t)row * 1024 + i * 256 + lane * 4) = w; }
    }
  }
}

DI void ssdprep_phase(const Params& p) {
  char* ws = p.ws;
  const int tid = tid_(), lane = tid & 63;
  {
    float* dtb = (float*)(ws + OFF_DT); float* csb = (float*)(ws + OFF_CS);
    const int gw = blockIdx.x * 8 + (tid >> 6), nw = gridDim.x * 8;
    for (int it = gw; it < 8192; it += nw) {
      const int hd = it & 31, bc = it >> 5;
      const size_t t0 = (size_t)bc * 128;
      const float a_neg = -expf(p.a_log[hd]), dtbias = p.dt_bias[hd];
      const float r0 = dtb[(t0 + 2 * lane) * 32 + hd] + dtbias, r1 = dtb[(t0 + 2 * lane + 1) * 32 + hd] + dtbias;
      const float d0 = fmaxf(r0, 0.f) + log1pf(expf(-fabsf(r0))), d1 = fmaxf(r1, 0.f) + log1pf(expf(-fabsf(r1)));
      const float a0 = d0 * a_neg, a1 = d1 * a_neg;
      float s = a0 + a1;
#pragma unroll
      for (int d = 1; d < 64; d <<= 1) { const float o = __shfl_up(s, d, 64); if (lane >= d) s += o; }
      dtb[(t0 + 2 * lane) * 32 + hd] = d0; dtb[(t0 + 2 * lane + 1) * 32 + hd] = d1;
      csb[(t0 + 2 * lane) * 32 + hd] = s - a1; csb[(t0 + 2 * lane + 1) * 32 + hd] = s;
    }
  }
  {
    u16* X = (u16*)(ws + OFF_XBC); const u16* H = (const u16*)(ws + OFF_HALO);
    const size_t gid = (size_t)blockIdx.x * NT + tid, gstride = (size_t)gridDim.x * NT;
    for (size_t task = gid; task < (size_t)512 * 384; task += gstride) {
      const int cg = (int)(task % 384), rt = (int)(task / 384), ch = cg * 8;
      float cw[4][8], cb[8];
#pragma unroll
      for (int k = 0; k < 4; ++k)
#pragma unroll
        for (int e = 0; e < 8; ++e) cw[k][e] = p.ssd_conv_w[k * 3072 + ch + e];
#pragma unroll
      for (int e = 0; e < 8; ++e) cb[e] = p.ssd_conv_b[ch + e];
      float w0[8], w1[8], w2[8];
      if ((rt & 63) == 0) {
#pragma unroll
        for (int e = 0; e < 8; ++e) { w0[e] = 0.f; w1[e] = 0.f; w2[e] = 0.f; }
      } else {
        const u16* hp = H + (size_t)(rt - 1) * 3 * 3072 + ch;
        unpack8(*(const u32x4*)(hp), w0); unpack8(*(const u32x4*)(hp + 3072), w1); unpack8(*(const u32x4*)(hp + 2 * 3072), w2);
      }
      u16* xp = X + (size_t)rt * 64 * 3072 + ch;
      for (int r8 = 0; r8 < 64; r8 += 8) {
        u32x4 raw[8];
#pragma unroll
        for (int i = 0; i < 8; ++i) raw[i] = *(const u32x4*)(xp + (size_t)(r8 + i) * 3072);
#pragma unroll
        for (int i = 0; i < 8; ++i) {
          float f[8], o[8]; unpack8(raw[i], f);
#pragma unroll
          for (int e = 0; e < 8; ++e) {
            o[e] = siluf_(cb[e] + cw[0][e] * w0[e] + cw[1][e] * w1[e] + cw[2][e] * w2[e] + cw[3][e] * f[e]);
            w0[e] = w1[e]; w1[e] = w2[e]; w2[e] = f[e];
          }
          *(u32x4*)(xp + (size_t)(r8 + i) * 3072) = pack8(o);
        }
      }
    }
  }
}

DI void ygscale_phase(const Params& p) {
  char* ws = p.ws;
  u16* yg = (u16*)(ws + OFF_Z); const float* ss = (const float*)(ws + OFF_SS);
  const size_t gid = (size_t)blockIdx.x * NT + tid_(), gstride = (size_t)gridDim.x * NT;
  for (size_t u = gid; u < (size_t)T * 256; u += gstride) {
    const size_t t = u >> 8; const int c8 = (int)(u & 255) * 8;
    const float rs = rsqrtf(ss[t * 4 + (c8 >> 9)] * (1.0f / 512.0f) + 1e-6f);
    u32x4* ptr = (u32x4*)(yg + t * 2048 + c8);
    float f[8]; unpack8(*ptr, f);
#pragma unroll
    for (int e = 0; e < 8; ++e) f[e] *= rs;
    *ptr = pack8(f);
  }
}

#define LAS3 __attribute__((address_space(3)))
DI unsigned off_b(unsigned row, unsigned ch) { return 256u * row + 16u * (ch ^ (((row & 3) << 2) | ((row >> 2) & 3))); }
DI unsigned tr_addr(int lane, unsigned row0, unsigned c) {
  const unsigned blk = (lane >> 4) & 1, q = (lane & 15) >> 2, pp = lane & 3;
  return off_b(row0 + q, 4 * c + 2 * blk + (pp >> 1)) + 8 * (pp & 1);
}
DI s16x4 tr_read(const char* img, unsigned off) { return __builtin_amdgcn_ds_read_tr16_b64_v4i16((LAS3 s16x4*)(img + off)); }
DI bf16x8 tr_frag(const char* img, unsigned o0, unsigned o1) {
  const s16x4 lo = tr_read(img, o0), hi = tr_read(img, o1);
  return __builtin_shufflevector(lo, hi, 0, 1, 2, 3, 4, 5, 6, 7);
}
constexpr int SS_ST = 136;
DI void ssd_item(const Params& p, int item, char* smem) {
  char* ws = p.ws;
  const int b = item >> 5, hd = item & 31, g = hd >> 3;
  char* Bs = smem;
  char* Xs = smem + 32768;
  char* Xw = smem + 2 * 32768;
  u16* Cs = (u16*)(smem + 3 * 32768);
  u16* St = (u16*)(smem + 3 * 32768 + 34816);
  float* cs = (float*)(smem + 3 * 32768 + 34816 + 17408);
  float* dts = cs + 128;
  const int tid = tid_(), lane = tid & 63, w = tid >> 6, r = lane & 31, h = lane >> 5;
  const float Dh = p.ssd_d[hd];
  u16* Zb = (u16*)(ws + OFF_Z);
  const u16* Xg = (const u16*)(ws + OFF_XBC);
  const float* dtb = (const float*)(ws + OFF_DT);
  const float* csb = (const float*)(ws + OFF_CS);
  float* ssb = (float*)(ws + OFF_SS);
  const int xch = tid & 7, xl = tid >> 3;
  const int bch = tid & 15, bl = tid >> 4;
  f32x16 stacc;
#pragma unroll
  for (int e = 0; e < 16; ++e) stacc[e] = 0.f;
  for (int i = tid; i < 64 * SS_ST / 2; i += NT) ((unsigned*)St)[i] = 0u;
  const int lt = (w < 4) ? w : 7 - w, pt = w >> 2, nt = w & 3;
  u32x4 px[2], pb[4], pc[4];
  float pdt[2], pcx[2], pcsT, pcl;
  auto prefetch = [&](int c) {
    const size_t t0 = (size_t)b * SEQ + c * 128;
#pragma unroll
    for (int i = 0; i < 2; ++i) {
      px[i] = *(const u32x4*)(Xg + (t0 + xl + 64 * i) * 3072 + hd * 64 + xch * 8);
      pdt[i] = dtb[(t0 + xl + 64 * i) * 32 + hd];
      pcx[i] = csb[(t0 + xl + 64 * i) * 32 + hd];
    }
#pragma unroll
    for (int i = 0; i < 4; ++i) {
      pb[i] = *(const u32x4*)(Xg + (t0 + bl + 32 * i) * 3072 + 2048 + g * 128 + bch * 8);
      pc[i] = *(const u32x4*)(Xg + (t0 + bl + 32 * i) * 3072 + 2560 + g * 128 + bch * 8);
    }
    pcsT = csb[(t0 + 127) * 32 + hd];
    pcl = (tid < 128) ? csb[(t0 + tid) * 32 + hd] : dtb[(t0 + (tid & 127)) * 32 + hd];
  };
  prefetch(0);
  for (int c = 0; c < 32; ++c) {
    const size_t t0 = (size_t)b * SEQ + c * 128;
    const float csT = pcsT;
    if (tid < 256) cs[tid] = pcl;
#pragma unroll
    for (int i = 0; i < 2; ++i) {
      const int l = xl + 64 * i;
      *(u32x4*)(Xs + off_b(l, xch)) = px[i];
      const float sc = pdt[i] * fast_exp(csT - pcx[i]);
      float f[8]; unpack8(px[i], f);
#pragma unroll
      for (int e = 0; e < 8; ++e) f[e] *= sc;
      *(u32x4*)(Xw + off_b(l, xch)) = pack8(f);
    }
#pragma unroll
    for (int i = 0; i < 4; ++i) {
      const int l = bl + 32 * i;
      *(u32x4*)(Bs + off_b(l, bch)) = pb[i];
      *(u32x4*)(Cs + l * SS_ST + bch * 8) = pc[i];
    }
    __syncthreads();
    {
      const int l = lt * 32 + r;
      const size_t t = t0 + l;
      u16* zrow = Zb + t * 2048 + hd * 64;
      u32x2 zv[4];
#pragma unroll
      for (int gq = 0; gq < 4; ++gq) zv[gq] = *(const u32x2*)(zrow + pt * 32 + 8 * gq + 4 * h);
      if (c + 1 < 32) prefetch(c + 1);
      const float csl = cs[l];
      f32x16 yd;
#pragma unroll
      for (int e = 0; e < 16; ++e) yd[e] = 0.f;
#pragma unroll
      for (int ks = 0; ks < 8; ++ks) {
        const bf16x8 sf = ld_frag16(St + (pt * 32 + r) * SS_ST + ks * 16 + h * 8);
        const bf16x8 cf = ld_frag16(Cs + l * SS_ST + ks * 16 + h * 8);
        yd = MFMA32(sf, cf, yd);
      }
      {
        const float el = fast_exp(csl);
#pragma unroll
        for (int e = 0; e < 16; ++e) yd[e] *= el;
      }
      for (int st = 0; st <= lt; ++st) {
        f32x16 cb_;
#pragma unroll
        for (int e = 0; e < 16; ++e) cb_[e] = 0.f;
#pragma unroll
        for (int ks = 0; ks < 8; ++ks) {
          const bf16x8 bf = *(const bf16x8*)(Bs + off_b(st * 32 + r, 2 * ks + h));
          const bf16x8 cf = ld_frag16(Cs + l * SS_ST + ks * 16 + h * 8);
          cb_ = MFMA32(bf, cf, cb_);
        }
        {
          const int lim = l - st * 32;
#pragma unroll
          for (int gq = 0; gq < 4; ++gq) {
            const f32x4 cs4 = *(const f32x4*)(cs + st * 32 + 8 * gq + 4 * h), dt4 = *(const f32x4*)(dts + st * 32 + 8 * gq + 4 * h);
#pragma unroll
            for (int e = 0; e < 4; ++e) {
              const float v = cb_[4 * gq + e] * fast_exp(fminf(csl - cs4[e], 0.f)) * dt4[e];
              cb_[4 * gq + e] = (8 * gq + 4 * h + e <= lim) ? v : 0.f;
            }
          }
        }
#pragma unroll
        for (int s2 = 0; s2 < 2; ++s2) {
          const bf16x8 pf = pack_frag(cb_, s2);
          const unsigned row0 = st * 32 + 16 * s2 + 4 * h;
          const bf16x8 xf = tr_frag(Xs, tr_addr(lane, row0, pt), tr_addr(lane, row0 + 8, pt));
          yd = MFMA32(xf, pf, yd);
        }
      }
      float ssq = 0.f;
#pragma unroll
      for (int gq = 0; gq < 4; ++gq) {
        const int pb_ = pt * 32 + 8 * gq + 4 * h;
        const u32x2 xv = *(const u32x2*)(Xs + off_b(l, pb_ >> 3) + (pb_ & 7) * 2);
        const float y0 = (yd[4 * gq] + Dh * bflo(xv.x)) * bflo(zv[gq].x);
        const float y1 = (yd[4 * gq + 1] + Dh * bfhi(xv.x)) * bfhi(zv[gq].x);
        const float y2 = (yd[4 * gq + 2] + Dh * bflo(xv.y)) * bflo(zv[gq].y);
        const float y3 = (yd[4 * gq + 3] + Dh * bfhi(xv.y)) * bfhi(zv[gq].y);
        ssq += (y0 * y0 + y1 * y1) + (y2 * y2 + y3 * y3);
        u32x2 ov; ov.x = pk2(y0, y1); ov.y = pk2(y2, y3);
        *(u32x2*)(zrow + pb_) = ov;
      }
      ssq += __shfl_xor(ssq, 32);
      if (h == 0) atomicAdd(ssb + t * 4 + g, ssq);
    }
    {
      const float dT = fast_exp(csT);
#pragma unroll
      for (int e = 0; e < 16; ++e) stacc[e] *= dT;
#pragma unroll
      for (int ks = 0; ks < 8; ++ks) {
        const unsigned row0 = 16 * ks + 8 * h;
        const bf16x8 bf = tr_frag(Bs, tr_addr(lane, row0, nt), tr_addr(lane, row0 + 4, nt));
        const bf16x8 xf = tr_frag(Xw, tr_addr(lane, row0, pt), tr_addr(lane, row0 + 4, pt));
        stacc = MFMA32(bf, xf, stacc);
      }
    }
    __syncthreads();
#pragma unroll
    for (int gq = 0; gq < 4; ++gq) {
      u32x2 ov; ov.x = pk2(stacc[4 * gq], stacc[4 * gq + 1]); ov.y = pk2(stacc[4 * gq + 2], stacc[4 * gq + 3]);
      *(u32x2*)(St + (pt * 32 + r) * SS_ST + nt * 32 + 8 * gq + 4 * h) = ov;
    }
  }
  __syncthreads();
}

#define XB_TMO      128
#define XB_XCNT(j)  (256  + 64 * (j))
#define XB_XSUB(j)  (1280 + 64 * (j))
#define XB_XGEN(j)  (2304 + 64 * (j))
#define XB_TOP      3328
#define XB_TOPGEN   3392
#define XCD_BAR_WORDS 3456
#define XB_SPIN_CAP (1u << 18)
#define XLAS __attribute__((address_space(3)))

__device__ __forceinline__ unsigned xb_ld(unsigned* p)              { return __hip_atomic_load(p, __ATOMIC_RELAXED, __HIP_MEMORY_SCOPE_AGENT); }
__device__ __forceinline__ unsigned xb_add(unsigned* p, unsigned v) { return __hip_atomic_fetch_add(p, v, __ATOMIC_RELAXED, __HIP_MEMORY_SCOPE_AGENT); }
__device__ __forceinline__ unsigned xb_xcc_id() { return (unsigned)__builtin_amdgcn_s_getreg((3 << 11) | 20) & 0xFu; }
#define XB_SPIN(cond, bar) do { unsigned _sp = 0; while (cond) { __builtin_amdgcn_s_sleep(1); \
    if ((++_sp & 255u) == 0u) { if (xb_ld(&(bar)[XB_TMO])) break; if (_sp > XB_SPIN_CAP) { atomicAdd(&(bar)[XB_TMO], 1u); break; } } } } while (0)

struct XcdBarrier {
    unsigned* bar; unsigned x;
    volatile XLAS unsigned* st;
};

__device__ __forceinline__ XcdBarrier xcd_barrier_post(unsigned* bar, volatile XLAS unsigned* st) {
    XcdBarrier b; b.bar = bar; b.x = xb_xcc_id(); b.st = st;
    if (tid_() == 0) (void)xb_add(&bar[XB_XCNT(b.x)], 1u);
    return b;
}
__device__ __forceinline__ void xcd_barrier_complete(unsigned* bar, unsigned x, unsigned& nloc, unsigned& nx) {
    const unsigned G = gridDim.x * gridDim.y * gridDim.z;
    unsigned sum, cnt, mine, sp = 0u;
    for (;;) {
        sum = 0u; cnt = 0u; mine = 0u;
#pragma unroll
        for (unsigned j = 0; j < 16; ++j) { const unsigned c = xb_ld(&bar[XB_XCNT(j)]); sum += c; cnt += (c > 0u) ? 1u : 0u; mine = (j == x) ? c : mine; }
        if (sum == G) break;
        __builtin_amdgcn_s_sleep(1);
        if ((++sp & 255u) == 0u) { if (xb_ld(&bar[XB_TMO])) break; if (sp > XB_SPIN_CAP) { atomicAdd(&bar[XB_TMO], 1u); break; } }
    }
    nloc = mine > 0u ? mine : 1u; nx = cnt > 0u ? cnt : 1u;
}

__device__ __forceinline__ void xcd_barrier(const XcdBarrier& b) {
    asm volatile("s_waitcnt vmcnt(0)" ::: "memory");
    __syncthreads();
    if (tid_() == 0) {
        unsigned* bar = b.bar;
        __builtin_amdgcn_s_waitcnt(0);
        unsigned nloc = b.st[0], nx = b.st[1];
        if (nloc == 0u) { xcd_barrier_complete(bar, b.x, nloc, nx); b.st[0] = nloc; b.st[1] = nx; }
        const unsigned old = xb_add(&bar[XB_XSUB(b.x)], 1u);
        const unsigned gen = old / nloc;
        if (old + 1u == (gen + 1u) * nloc) {
            __builtin_amdgcn_fence(__ATOMIC_RELEASE, "agent");
            asm volatile("s_waitcnt vmcnt(0)" ::: "memory");
            const unsigned og = xb_add(&bar[XB_TOP], 1u);
            const unsigned tg = og / nx;
            if (og + 1u == (tg + 1u) * nx) xb_add(&bar[XB_TOPGEN], 1u);
            else XB_SPIN(xb_ld(&bar[XB_TOPGEN]) == tg, bar);
            __builtin_amdgcn_fence(__ATOMIC_ACQUIRE, "agent");
            xb_add(&bar[XB_XGEN(b.x)], 1u);
            asm volatile("s_waitcnt vmcnt(0)" ::: "memory");
        } else {
            XB_SPIN(xb_ld(&bar[XB_XGEN(b.x)]) == gen, bar);
            __builtin_amdgcn_fence(__ATOMIC_ACQUIRE, "agent");
            asm volatile("s_waitcnt vmcnt(0)" ::: "memory");
        }
    }
    __syncthreads();
}

__global__ void __launch_bounds__(NT) fwd_megakernel(Params p) {
  __shared__ __attribute__((aligned(16))) char smem[160 * 1024];
  cg::grid_group grid = cg::this_grid();
  char* ws = p.ws;
  const int nb = gridDim.x, bid = blockIdx.x;
  int rot = 0;
  volatile XLAS unsigned* xst = (volatile XLAS unsigned*)(smem + 163824);
  if (tid_() == 0) { xst[0] = 0u; xst[1] = 0u; xst[2] = 0u; xst[3] = 0u; }
  __syncthreads();
  const XcdBarrier xb = xcd_barrier_post((unsigned*)(ws + OFF_BAR), xst);
  if (p.pos == nullptr) grid.sync();
  phase_prep(p, smem);
  xcd_barrier(xb);
  { EpiProj0 E; E.O = (u16*)(ws + OFF_PROJ0); pg8_run((const u16*)(ws + OFF_XB), 1024, (const u16*)(ws + OFF_W1T), 2048, 1024, E, smem); }
  xcd_barrier(xb);
  for (int it = (bid + nb - rot) % nb; it < 2048; it += nb) rglru_item(p, it, smem);
  rot = (rot + 2048) % nb;
  gemm_phase<2>(p, (const u16*)(ws + OFF_PROJ0) + 1536, LD0, (const u16*)(ws + OFF_WQT), 256, 768, rot, smem);
  gemm_phase<3>(p, (const u16*)(ws + OFF_PROJ0) + 1792, LD0, (const u16*)(ws + OFF_WKVT), 128, 1024, rot, smem);
  for (int it = (bid + nb - rot) % nb; it < 128; it += nb) krope_item(p, it);
  rot = (rot + 128) % nb;
  xcd_barrier(xb);
  for (int it = bid; it < 1024; it += nb) {
    const int j = it & 255, i = it >> 8, g = j >> 6, bh = j & 63;
    const int qb = (i == 0) ? 15 - g : (i == 1) ? 8 + g : (i == 2) ? 7 - g : g;
    attn_item(p, bh, qb, smem);
  }
  for (int it = bid; it < 256; it += nb) fixup_item(p, it, smem);
  xcd_barrier(xb);
  rot = 0;
  { EpiResid<false> E; E.src = p.x; E.dst = p.out; E.ss = nullptr; pg8_run((const u16*)(ws + OFF_YCAT), 1024, (const u16*)(ws + OFF_WOT), 1024, 1024, E, smem); }
  xcd_barrier(xb);
  ln_phase(p, p.ab_ln_g, p.ab_ln_b, (u16*)(ws + OFF_X1B));
  xcd_barrier(xb);
  rot = 0;
  { EpiProj1 E; E.Z = (u16*)(ws + OFF_Z); E.X = (u16*)(ws + OFF_XBC); E.H = (u16*)(ws + OFF_HALO); E.dt = (float*)(ws + OFF_DT); pg8_run((const u16*)(ws + OFF_X1B), 1024, (const u16*)(ws + OFF_W2T), 5376, 1024, E, smem); }
  xcd_barrier(xb);
  ssdprep_phase(p);
  xcd_barrier(xb);
  for (int it = bid; it < 256; it += nb) {
    const int x = it & 7, slot = it >> 3, grp = x * 4 + (slot >> 3);
    ssd_item(p, (grp >> 2) * 32 + (grp & 3) * 8 + (slot & 7), smem);
  }
  xcd_barrier(xb);
  ygscale_phase(p);
  xcd_barrier(xb);
  rot = 0;
  { EpiResid<false> E; E.src = p.out; E.dst = p.out; E.ss = nullptr; pg8_run((const u16*)(ws + OFF_Z), 2048, (const u16*)(ws + OFF_W3T), 1024, 2048, E, smem); }
  xcd_barrier(xb);
  ln_phase(p, p.ssd_ln_g, p.ssd_ln_b, nullptr);
}

extern "C" void kernel_launch(void* const* d_in, const int* in_sizes, int n_in, void* d_out, int out_size, void* d_ws, size_t ws_size, hipStream_t stream) {
  static int grid_blocks = 0;
  if (!grid_blocks) {
    int dev = 0, cus = 0, per_cu = 0;
    hipGetDevice(&dev);
    hipDeviceGetAttribute(&cus, hipDeviceAttributeMultiprocessorCount, dev);
    hipOccupancyMaxActiveBlocksPerMultiprocessor(&per_cu, fwd_megakernel, NT, 0);
    if (per_cu < 1) per_cu = 1;
    grid_blocks = cus * per_cu;
  }
  Params p{};
  p.x = (const float*)d_in[0]; p.pos = (const int*)d_in[1];
  p.ab_w_in = (const float*)d_in[2]; p.ab_conv_w = (const float*)d_in[3]; p.ab_conv_b = (const float*)d_in[4];
  p.ga_w = (const float*)d_in[5]; p.ga_b = (const float*)d_in[6]; p.gx_w = (const float*)d_in[7]; p.gx_b = (const float*)d_in[8];
  p.lam = (const float*)d_in[9]; p.qn = (const float*)d_in[10]; p.kvn = (const float*)d_in[11]; p.w_uq = (const float*)d_in[12];
  p.w_ukv = (const float*)d_in[13]; p.ab_w_out = (const float*)d_in[14]; p.ab_ln_g = (const float*)d_in[15]; p.ab_ln_b = (const float*)d_in[16];
  p.ssd_w_in = (const float*)d_in[17]; p.ssd_conv_w = (const float*)d_in[18]; p.ssd_conv_b = (const float*)d_in[19]; p.dt_bias = (const float*)d_in[20];
  p.a_log = (const float*)d_in[21]; p.ssd_d = (const float*)d_in[22]; p.ssd_norm = (const float*)d_in[23]; p.ssd_w_out = (const float*)d_in[24];
  p.ssd_ln_g = (const float*)d_in[25]; p.ssd_ln_b = (const float*)d_in[26];
  p.out = (float*)d_out; p.ws = (char*)d_ws;
  hipMemsetAsync((char*)d_ws + OFF_BAR, 0, XCD_BAR_WORDS * sizeof(unsigned), stream);
  void* args[] = {&p};
  hipError_t e = hipLaunchCooperativeKernel((void*)fwd_megakernel, dim3(grid_blocks), dim3(NT), args, 0, stream);
  if (e != hipSuccess) fprintf(stderr, "cooperative launch failed: %s (grid %d)\n", hipGetErrorString(e), grid_blocks);
}
```

```cpp
#include <hip/hip_runtime.h>
#include <hip/hip_cooperative_groups.h>
#include <cstdio>
namespace cg = cooperative_groups;

typedef unsigned short u16;
typedef short bf16x8 __attribute__((ext_vector_type(8)));
typedef short s16x4 __attribute__((ext_vector_type(4)));
typedef float f32x16 __attribute__((ext_vector_type(16)));
typedef float f32x4 __attribute__((ext_vector_type(4)));
typedef unsigned u32x4 __attribute__((ext_vector_type(4)));
typedef unsigned u32x2 __attribute__((ext_vector_type(2)));
typedef __bf16 bf2_t __attribute__((ext_vector_type(2)));

#define DI __device__ __forceinline__
#define NT 512
__device__ __forceinline__ int tid_() { int t = threadIdx.x; asm volatile("" : "+v"(t)); return t; }
#define MFMA32(a, b, c) __builtin_amdgcn_mfma_f32_32x32x16_bf16((a), (b), (c), 0, 0, 0)

constexpr int T = 32768, SEQ = 4096;
constexpr float DN_ALPHA = 1.41421356237309515f;
constexpr size_t Mi = 1024ull * 1024ull;
constexpr size_t OFF_W1T = 0, OFF_WOT = 4 * Mi, OFF_W2T = 6 * Mi, OFF_W3T = 16 * Mi + 512 * 1024, OFF_WQT = 20 * Mi + 512 * 1024,
                 OFF_WKVT = 21 * Mi, OFF_WAT = 21 * Mi + 256 * 1024, OFF_WXT = 21 * Mi + 320 * 1024, OFF_COS = 21 * Mi + 512 * 1024,
                 OFF_SIN = 23 * Mi + 512 * 1024, OFF_HEND = 25 * Mi + 512 * 1024, OFF_PEND = 26 * Mi, OFF_SS = 26 * Mi + 512 * 1024,
                 OFF_DT = 27 * Mi, OFF_XB = 32 * Mi, OFF_YCAT = 32 * Mi, OFF_X1B = 32 * Mi, OFF_BC = 32 * Mi, OFF_PROJ0 = 96 * Mi,
                 OFF_HLOC = 224 * Mi, OFF_PCUM = 256 * Mi, OFF_Q = 288 * Mi, OFF_KC = 336 * Mi, OFF_VT = 384 * Mi, OFF_PROJ1 = 96 * Mi,
                 OFF_Z = 96 * Mi, OFF_XBC = 224 * Mi, OFF_HALO = 416 * Mi, OFF_CS = 436 * Mi, OFF_SP = 31 * Mi, OFF_BAR = 31 * Mi + 65536;
constexpr int LD0 = 2048, LD1 = 5376;

struct Params {
  const float* x; const int* pos;
  const float *ab_w_in, *ab_conv_w, *ab_conv_b, *ga_w, *ga_b, *gx_w, *gx_b, *lam, *qn, *kvn, *w_uq, *w_ukv, *ab_w_out, *ab_ln_g, *ab_ln_b;
  const float *ssd_w_in, *ssd_conv_w, *ssd_conv_b, *dt_bias, *a_log, *ssd_d, *ssd_norm, *ssd_w_out, *ssd_ln_g, *ssd_ln_b;
  float* out; char* ws;
};

DI unsigned pk2(float a, float b) { bf2_t v; v[0] = (__bf16)a; v[1] = (__bf16)b; return __builtin_bit_cast(unsigned, v); }
DI u16 f2bf(float a) { __bf16 v = (__bf16)a; return __builtin_bit_cast(u16, v); }
DI float bflo(unsigned w) { return __uint_as_float(w << 16); }
DI float bfhi(unsigned w) { return __uint_as_float(w & 0xffff0000u); }
DI float bf2f(u16 v) { return __uint_as_float(((unsigned)v) << 16); }
DI float fast_exp2(float x) { return __builtin_amdgcn_exp2f(x); }
DI float fast_exp(float x) { return __builtin_amdgcn_exp2f(x * 1.44269504088896341f); }
DI float fast_rcp(float x) { return __builtin_amdgcn_rcpf(x); }
DI float sigmoidf_(float x) { return fast_rcp(1.0f + fast_exp(-x)); }
DI float siluf_(float x) { return x * sigmoidf_(x); }
DI int crow(int i, int h) { return (i & 3) + 8 * (i >> 2) + 4 * h; }
DI void unpack8(const u32x4& v, float* f) {
  f[0] = bflo(v.x); f[1] = bfhi(v.x); f[2] = bflo(v.y); f[3] = bfhi(v.y); f[4] = bflo(v.z); f[5] = bfhi(v.z); f[6] = bflo(v.w); f[7] = bfhi(v.w);
}
DI u32x4 pack8(const float* f) { u32x4 v; v.x = pk2(f[0], f[1]); v.y = pk2(f[2], f[3]); v.z = pk2(f[4], f[5]); v.w = pk2(f[6], f[7]); return v; }
DI bf16x8 pack_frag(const f32x16& x, int s) {
  u32x4 v; v.x = pk2(x[8 * s], x[8 * s + 1]); v.y = pk2(x[8 * s + 2], x[8 * s + 3]); v.z = pk2(x[8 * s + 4], x[8 * s + 5]); v.w = pk2(x[8 * s + 6], x[8 * s + 7]);
  return __builtin_bit_cast(bf16x8, v);
}
DI bf16x8 ld_frag16(const u16* p) { return *(const bf16x8*)p; }
DI bf16x8 ld_frag8x2(const u16* p0, const u16* p1) {
  s16x4 lo = *(const s16x4*)p0, hi = *(const s16x4*)p1;
  return __builtin_shufflevector(lo, hi, 0, 1, 2, 3, 4, 5, 6, 7);
}

DI void tr_tile(const float* __restrict__ src, u16* __restrict__ dst, int K, int N, const float* __restrict__ scale, int kt, int nt, char* smem) {
  float* tf = (float*)smem;
  const int tid = tid_(), k0 = kt * 64, n0 = nt * 64;
#pragma unroll
  for (int i = 0; i < 8; ++i) {
    const int kk = (tid >> 6) + 8 * i, nn = tid & 63;
    float v = 0.f;
    if (n0 + nn < N) { v = src[(size_t)(k0 + kk) * N + n0 + nn]; if (scale) v *= scale[k0 + kk]; }
    tf[kk * 65 + nn] = v;
  }
  __syncthreads();
#pragma unroll
  for (int i = 0; i < 8; ++i) {
    const int nn = (tid >> 6) + 8 * i, kk = tid & 63;
    dst[(size_t)(n0 + nn) * K + k0 + kk] = f2bf(tf[kk * 65 + nn]);
  }
  __syncthreads();
}
DI void tr_job(const float* src, u16* dst, int K, int N, int Npad, const float* scale, int& rot, char* smem) {
  const int nkt = K / 64, nnt = Npad / 64, n = nkt * nnt, nb = gridDim.x;
  for (int it = (blockIdx.x + nb - rot) % nb; it < n; it += nb) tr_tile(src, dst, K, N, scale, it % nkt, it / nkt, smem);
  rot = (rot + n) % nb;
}

DI void phase_prep(const Params& p, char* smem) {
  char* ws = p.ws;
  int rot = 0;
  tr_job(p.ab_w_in, (u16*)(ws + OFF_W1T), 1024, 1952, 2048, nullptr, rot, smem);
  tr_job(p.ssd_w_in, (u16*)(ws + OFF_W2T), 1024, 5152, 5376, nullptr, rot, smem);
  tr_job(p.ab_w_out, (u16*)(ws + OFF_WOT), 1024, 1024, 1024, nullptr, rot, smem);
  tr_job(p.ssd_w_out, (u16*)(ws + OFF_W3T), 2048, 1024, 1024, p.ssd_norm, rot, smem);
  tr_job(p.w_uq, (u16*)(ws + OFF_WQT), 256, 768, 768, p.qn, rot, smem);
  tr_job(p.w_ukv, (u16*)(ws + OFF_WKVT), 128, 1024, 1024, p.kvn, rot, smem);
  for (int hd = 0; hd < 8; ++hd) {
    tr_job(p.ga_w + hd * 4096, (u16*)(ws + OFF_WAT) + hd * 4096, 64, 64, 64, nullptr, rot, smem);
    tr_job(p.gx_w + hd * 4096, (u16*)(ws + OFF_WXT) + hd * 4096, 64, 64, 64, nullptr, rot, smem);
  }
  const size_t gid = (size_t)blockIdx.x * NT + tid_(), gstride = (size_t)gridDim.x * NT;
  {
    const f32x4* xs = (const f32x4*)p.x; u32x4* xb = (u32x4*)(ws + OFF_XB);
    const size_t n8 = (size_t)T * 1024 / 8;
    for (size_t i = gid; i < n8; i += 4 * gstride) {
      f32x4 a[4], b[4];
#pragma unroll
      for (int k = 0; k < 4; ++k) { const size_t j = i + k * gstride; if (j < n8) { a[k] = xs[2 * j]; b[k] = xs[2 * j + 1]; } }
#pragma unroll
      for (int k = 0; k < 4; ++k) { const size_t j = i + k * gstride; if (j < n8) {
        u32x4 o; o.x = pk2(a[k].x, a[k].y); o.y = pk2(a[k].z, a[k].w); o.z = pk2(b[k].x, b[k].y); o.w = pk2(b[k].z, b[k].w);
        xb[j] = o; } }
    }
  }
  {
    float* ct = (float*)(ws + OFF_COS); float* st = (float*)(ws + OFF_SIN);
    for (size_t i = gid; i < (size_t)T * 16; i += gstride) {
      const int t = (int)(i >> 4), j = (int)(i & 15);
      const float inv = exp2f(-(float)j * (13.287712379549449f / 16.0f));
      const float ang = (float)p.pos[t] * inv;
      const double rev = (double)ang * 0.15915494309189535;
      const double fr = rev - rint(rev);
      const float a = (float)(fr * 6.283185307179586);
      ct[i] = cosf(a); st[i] = sinf(a);
    }
  }
  { float* sp = (float*)(ws + OFF_SP); for (size_t i = gid; i < 512; i += gstride) sp[i] = log1pf(expf(-p.lam[i])); }
  {
    float* ss = (float*)(ws + OFF_SS);
    for (size_t i = gid; i < (size_t)T * 4; i += gstride) ss[i] = 0.f;
  }
}

constexpr int GA_ST = 72;
constexpr float QSCALE = 0.10206207261596575f * 1.44269504088896341f;

template <int MODE>
DI void gemm_epi(const Params& p, int row, int colbase, int h, const f32x16& v, float rs) {
  char* ws = p.ws;
  if constexpr (MODE == 1) {
    u16* dst = (u16*)(ws + OFF_PROJ0) + (size_t)row * LD0;
#pragma unroll
    for (int g = 0; g < 4; ++g) {
      const int col = colbase + 8 * g + 4 * h;
      float a = v[4 * g], b = v[4 * g + 1], c = v[4 * g + 2], d = v[4 * g + 3];
      if (col >= 512 && col < 1536) { a = siluf_(a); b = siluf_(b); c = siluf_(c); d = siluf_(d); }
      u32x2 o; o.x = pk2(a, b); o.y = pk2(c, d);
      *(u32x2*)(dst + col) = o;
    }
  } else if constexpr (MODE == 2) {
    u16* dst = (u16*)(ws + OFF_Q) + (size_t)row * 768;
    f32x16 o;
    if ((colbase % 96) == 64) {
      const float* ct = (const float*)(ws + OFF_COS) + (size_t)row * 16;
      const float* st = (const float*)(ws + OFF_SIN) + (size_t)row * 16;
#pragma unroll
      for (int i = 0; i < 8; ++i) {
        const int idx = crow(i, h);
        const float c = ct[idx], s = st[idx], x1 = v[i] * rs, x2 = v[i + 8] * rs;
        o[i] = (x1 * c - x2 * s) * QSCALE; o[i + 8] = (x2 * c + x1 * s) * QSCALE;
      }
    } else {
#pragma unroll
      for (int i = 0; i < 16; ++i) o[i] = v[i] * (rs * QSCALE);
    }
#pragma unroll
    for (int g = 0; g < 4; ++g) {
      u32x2 w; w.x = pk2(o[4 * g], o[4 * g + 1]); w.y = pk2(o[4 * g + 2], o[4 * g + 3]);
      *(u32x2*)(dst + colbase + 8 * g + 4 * h) = w;
    }
  } else if constexpr (MODE == 3) {
    const int hd = colbase >> 7, within = colbase & 127;
    if (within < 64) {
      u16* dst = (u16*)(ws + OFF_KC) + (size_t)row * 768 + hd * 96 + within;
#pragma unroll
      for (int g = 0; g < 4; ++g) {
        u32x2 w; w.x = pk2(v[4 * g] * rs, v[4 * g + 1] * rs); w.y = pk2(v[4 * g + 2] * rs, v[4 * g + 3] * rs);
        *(u32x2*)(dst + 8 * g + 4 * h) = w;
      }
    } else {
      const int b = row >> 12, s = row & 4095;
      u16* dst = (u16*)(ws + OFF_VT) + ((size_t)(b * 8 + hd) * 64 + (within - 64)) * SEQ + s;
#pragma unroll
      for (int i = 0; i < 16; ++i) dst[(size_t)crow(i, h) * SEQ] = f2bf(v[i] * rs);
    }
  } else if constexpr (MODE == 4 || MODE == 6) {
    const float* src = (MODE == 4) ? p.x : p.out;
#pragma unroll
    for (int g = 0; g < 4; ++g) {
      const size_t off = (size_t)row * 1024 + colbase + 8 * g + 4 * h;
      const f32x4 xv = *(const f32x4*)(src + off);
      f32x4 o; o.x = DN_ALPHA * xv.x + v[4 * g]; o.y = DN_ALPHA * xv.y + v[4 * g + 1]; o.z = DN_ALPHA * xv.z + v[4 * g + 2]; o.w = DN_ALPHA * xv.w + v[4 * g + 3];
      *(f32x4*)(p.out + off) = o;
    }
  } else if constexpr (MODE == 5) {
    if (colbase < 5120) {
      u16* dst = (u16*)(ws + OFF_PROJ1) + (size_t)row * LD1;
#pragma unroll
      for (int g = 0; g < 4; ++g) {
        const int col = colbase + 8 * g + 4 * h;
        float a = v[4 * g], b = v[4 * g + 1], c = v[4 * g + 2], d = v[4 * g + 3];
        if (col < 2048) { a = siluf_(a); b = siluf_(b); c = siluf_(c); d = siluf_(d); }
        u32x2 o; o.x = pk2(a, b); o.y = pk2(c, d);
        *(u32x2*)(dst + col) = o;
      }
    } else if (colbase == 5120) {
      float* dst = (float*)(ws + OFF_DT) + (size_t)row * 32;
#pragma unroll
      for (int i = 0; i < 16; ++i) {
        const int c = crow(i, h);
        const float xv = v[i] + p.dt_bias[c];
        dst[c] = fmaxf(xv, 0.f) + log1pf(expf(-fabsf(xv)));
      }
    }
  }
}

template <int MODE>
DI void gemm_tile(const Params& p, const u16* __restrict__ A, int lda, const u16* __restrict__ Bt, int K, int m0, int n0, char* smem) {
  constexpr bool ROWNORM = (MODE == 2 || MODE == 3);
  constexpr bool GROUPS = (MODE == 6);
  u16* As = (u16*)smem;
  u16* Bs = (u16*)(smem + 2 * 256 * GA_ST * 2);
  float* ssrow = (float*)(smem + 2 * 256 * GA_ST * 2 + 2 * 128 * GA_ST * 2);
  const int tid = tid_(), lane = tid & 63, w = tid >> 6, wm = w & 3, wn = w >> 2, r = lane & 31, h = lane >> 5;
  const int lrow = tid >> 3, lkc = (tid & 7) * 8;
  const u16* ag = A + (size_t)(m0 + lrow) * lda + lkc;
  const u16* bg = Bt + (size_t)(n0 + lrow) * K + lkc;
  u32x4 ra[4], rb[2];
  float ssq[4] = {0.f, 0.f, 0.f, 0.f};
  f32x16 acc[2][2];
#pragma unroll
  for (int i = 0; i < 2; ++i)
#pragma unroll
    for (int j = 0; j < 2; ++j)
#pragma unroll
      for (int e = 0; e < 16; ++e) acc[i][j][e] = 0.f;
  const int nk = K / 64;
  auto gload = [&](int kt) {
#pragma unroll
    for (int i = 0; i < 4; ++i) ra[i] = *(const u32x4*)(ag + (size_t)(64 * i) * lda + kt * 64);
#pragma unroll
    for (int i = 0; i < 2; ++i) rb[i] = *(const u32x4*)(bg + (size_t)(64 * i) * K + kt * 64);
  };
  auto lstore = [&](int buf) {
    u16* as = As + buf * 256 * GA_ST; u16* bs = Bs + buf * 128 * GA_ST;
#pragma unroll
    for (int i = 0; i < 4; ++i) {
      *(u32x4*)(as + (lrow + 64 * i) * GA_ST + lkc) = ra[i];
      if constexpr (ROWNORM) { float f[8]; unpack8(ra[i], f);
#pragma unroll
        for (int e = 0; e < 8; ++e) ssq[i] += f[e] * f[e]; }
    }
#pragma unroll
    for (int i = 0; i < 2; ++i) *(u32x4*)(bs + (lrow + 64 * i) * GA_ST + lkc) = rb[i];
  };
  gload(0); lstore(0);
  __syncthreads();
  for (int kt = 0; kt < nk; ++kt) {
    const int buf = kt & 1;
    if (kt + 1 < nk) gload(kt + 1);
    const u16* as = As + buf * 256 * GA_ST + (wm * 64 + r) * GA_ST + h * 8;
    const u16* bs = Bs + buf * 128 * GA_ST + (wn * 64 + r) * GA_ST + h * 8;
#pragma unroll
    for (int ks = 0; ks < 4; ++ks) {
      const bf16x8 a0 = ld_frag16(as + ks * 16), a1 = ld_frag16(as + 32 * GA_ST + ks * 16);
      const bf16x8 b0 = ld_frag16(bs + ks * 16), b1 = ld_frag16(bs + 32 * GA_ST + ks * 16);
      acc[0][0] = MFMA32(b0, a0, acc[0][0]); acc[0][1] = MFMA32(b1, a0, acc[0][1]);
      acc[1][0] = MFMA32(b0, a1, acc[1][0]); acc[1][1] = MFMA32(b1, a1, acc[1][1]);
    }
    if constexpr (GROUPS) {
      if ((kt & 7) == 7) {
        const int g = kt >> 3;
        const float* ss = (const float*)(p.ws + OFF_SS);
#pragma unroll
        for (int mi = 0; mi < 2; ++mi) {
          const int row = m0 + wm * 64 + mi * 32 + r;
          const float sg = rsqrtf(ss[(size_t)row * 4 + g] * (1.0f / 512.0f) + 1e-6f);
          float sc = sg;
          if (g < 3) sc = sg * sqrtf(ss[(size_t)row * 4 + g + 1] * (1.0f / 512.0f) + 1e-6f);
#pragma unroll
          for (int ni = 0; ni < 2; ++ni)
#pragma unroll
            for (int e = 0; e < 16; ++e) acc[mi][ni][e] *= sc;
        }
      }
    }
    if (kt + 1 < nk) lstore(buf ^ 1);
    __syncthreads();
  }
  float rsv[2] = {1.f, 1.f};
  if constexpr (ROWNORM) {
#pragma unroll
    for (int i = 0; i < 4; ++i) {
      float s = ssq[i];
      s += __shfl_xor(s, 1); s += __shfl_xor(s, 2); s += __shfl_xor(s, 4);
      if ((tid & 7) == 0) ssrow[lrow + 64 * i] = s;
    }
    __syncthreads();
#pragma unroll
    for (int mi = 0; mi < 2; ++mi) rsv[mi] = rsqrtf(ssrow[wm * 64 + mi * 32 + r] / (float)K + 1e-6f);
  }
#pragma unroll
  for (int mi = 0; mi < 2; ++mi)
#pragma unroll
    for (int ni = 0; ni < 2; ++ni) {
      const int row = m0 + wm * 64 + mi * 32 + r, colbase = n0 + wn * 64 + ni * 32;
      gemm_epi<MODE>(p, row, colbase, h, acc[mi][ni], rsv[mi]);
    }
  __syncthreads();
}

template <int MODE>
DI void gemm_phase(const Params& p, const u16* A, int lda, const u16* Bt, int K, int Npad, int& rot, char* smem) {
  const int nN = Npad / 128, n = (T / 256) * nN, nb = gridDim.x;
  for (int it = (blockIdx.x + nb - rot) % nb; it < n; it += nb) gemm_tile<MODE>(p, A, lda, Bt, K, (it / nN) * 256, (it % nN) * 128, smem);
  rot = (rot + n) % nb;
}

namespace pg8 {
#define PG8_LAS __attribute__((address_space(3)))
typedef unsigned short bf16_t;
typedef short bf16x8 __attribute__((ext_vector_type(8)));
typedef float f32x4 __attribute__((ext_vector_type(4)));
typedef unsigned u32x4 __attribute__((ext_vector_type(4)));
constexpr int BM = 256, BK = 64, HALF = 128, HTB = HALF * BK * 2  , STAGE_BYTES = 8 * HTB, NXCD = 8, WGM = 8;

__host__ __device__ __forceinline__ int lds_byte(int r, int c) { const int st = (r >> 4) * 2 + (c >> 5), rr = r & 15, cc = c & 31, ob = rr * 64 + cc * 2; return st * 1024 + (ob ^ (((ob >> 9) & 1) << 5)); }
__host__ __device__ __forceinline__ void stage_rc(int b, int& R, int& C) { const int st = b / 1024, sb = b % 1024, swz = sb ^ (((sb >> 9) & 1) << 5); R = (st >> 1) * 16 + swz / 64; C = (st & 1) * 32 + (swz % 64) / 2; }
__host__ __device__ __forceinline__ int perm32(int rho) { const int n = rho >> 4, i = rho & 15; return 8 * (i >> 2) + 4 * n + (i & 3); }

struct Unit { int pm, pn; };
struct Gemm { const bf16_t* A; const bf16_t* Bt; int M, N, K, lda; };

struct StaticOrder {
    int nM, nN, nwg, G, c;
    __host__ __device__ void init(int M, int N, int G_, int c_) { nM = M / BM; nN = N / BM; nwg = nM * nN; G = G_; c = c_; }
    __host__ __device__ bool next(int i, Unit& u) const {
        const long L = (long)i * G + c; if (L >= nwg) return false;
        int wgid = (int)L; { const int q = nwg / NXCD, r = nwg % NXCD, xcd = wgid % NXCD, off = wgid / NXCD; wgid = (xcd < r ? xcd * (q + 1) : r * (q + 1) + (xcd - r) * q) + off; }
        const int nig = WGM * nN, gid = wgid / nig, fm = gid * WGM, gsz = (nM - fm) < WGM ? (nM - fm) : WGM;
        u.pm = fm + ((wgid % nig) % gsz); u.pn = (wgid % nig) / gsz; return true;
    }
    __device__ __forceinline__ void a_ready(const Unit&) const {}
    __device__ __forceinline__ void done(const Unit&) const {}
};
template <class Epi, class Sched, bool STAMP = false>
__device__ __forceinline__ void gemm_phase(PG8_LAS unsigned char* lds, const Gemm g, const Sched& S, const Epi& E, unsigned long long* stamps) {
    const int tid = tid_(), wid = __builtin_amdgcn_readfirstlane(tid >> 6), lane = tid & 63, wr = wid >> 2, wc = wid & 3, fr = lane & 15, fq = lane >> 4;
    const int K = g.K, nt = K / BK;
    int ts_lo = 0, ts_hi = 0, nts = 0; const unsigned long long rt_entry = STAMP ? (unsigned long long)wall_clock64() : 0ull;
#define PG8_STAMP() do { if (STAMP && wid == 0 && nts < 64) { const unsigned long long _c = (unsigned long long)clock64(); \
        ts_lo = (lane == nts) ? (int)(unsigned)_c : ts_lo; ts_hi = (lane == nts) ? (int)(unsigned)(_c >> 32) : ts_hi; ++nts; } } while (0)
    PG8_STAMP();
    unsigned voffA[2], voffB[2];
#pragma unroll
    for (int i = 0; i < 2; ++i) { int R, C; stage_rc(tid * 16 + i * 8192, R, C); const int Rb = Epi::PERM ? ((R & ~31) + perm32(R & 31)) : R;
        voffA[i] = (unsigned)(R * g.lda + C) * 2u; voffB[i] = (unsigned)(Rb * K + C) * 2u; }
    const size_t kstep = (size_t)(BK * 2);
    const size_t hstepA = (size_t)HALF * g.lda * 2, hstepB = (size_t)HALF * K * 2;
    const size_t tstepA = 2 * hstepA, tstepB = 2 * hstepB;
    const unsigned ldsw = (unsigned)wid * 1024u;
    const int aoff = lds_byte(wr * 64 + fr, fq * 8), boff = lds_byte(wc * 32 + fr, fq * 8);
#define PG8_SA(b, h) (((b) * 2 + (h)) * HTB)
#define PG8_SB(b, h) ((4 + (b) * 2 + (h)) * HTB)
#define PG8_STAGE(bufoff, gbase, voff) do { _Pragma("unroll") for (int _i = 0; _i < 2; ++_i) \
        __builtin_amdgcn_global_load_lds((const unsigned*)((const char*)(gbase) + (voff)[_i]), (PG8_LAS unsigned*)(lds + (bufoff) + ldsw + _i * 8192), 16, 0, 0); } while (0)
#define PG8_LDA(dst, b, h) do { _Pragma("unroll") for (int m = 0; m < 4; ++m) _Pragma("unroll") for (int k = 0; k < 2; ++k) dst[m][k] = *(const PG8_LAS bf16x8*)(lds + PG8_SA(b, h) + aoff + m * 2048 + k * 1024); } while (0)
#define PG8_LDB(dst, b, h) do { _Pragma("unroll") for (int n = 0; n < 2; ++n) _Pragma("unroll") for (int k = 0; k < 2; ++k) dst[n][k] = *(const PG8_LAS bf16x8*)(lds + PG8_SB(b, h) + boff + n * 2048 + k * 1024); } while (0)
#define PG8_MMA(ai, bj, At, Bt) do { __builtin_amdgcn_s_setprio(1); _Pragma("unroll") for (int m = 0; m < 4; ++m) _Pragma("unroll") for (int n = 0; n < 2; ++n) _Pragma("unroll") for (int k = 0; k < 2; ++k) \
        acc[ai][bj][m][n] = __builtin_amdgcn_mfma_f32_16x16x32_bf16(Bt[n][k], At[m][k], acc[ai][bj][m][n], 0, 0, 0); __builtin_amdgcn_s_setprio(0); } while (0)
#define PG8_WAIT_V(n) asm volatile("s_waitcnt vmcnt(" #n ")" ::: "memory")
#define PG8_WAIT_L(n) asm volatile("s_waitcnt lgkmcnt(" #n ")" ::: "memory")
#define PG8_BAR __builtin_amdgcn_s_barrier()
#define PG8_SCHED __builtin_amdgcn_sched_barrier(0)
    Unit cur, nxt; int ui = 0;
    if (!S.next(0, cur)) return;
    f32x4 acc[2][2][4][2];
#pragma unroll
    for (int a = 0; a < 2; ++a)
#pragma unroll
        for (int b = 0; b < 2; ++b)
#pragma unroll
            for (int m = 0; m < 4; ++m)
#pragma unroll
                for (int n = 0; n < 2; ++n) acc[a][b][m][n] = (f32x4){0.f, 0.f, 0.f, 0.f};
    bf16x8 At[4][2], B0[2][2], B1[2][2];
    const char* cA = (const char*)g.A + (size_t)cur.pm * tstepA; const char* cB = (const char*)g.Bt + (size_t)cur.pn * tstepB;
    S.a_ready(cur);
    PG8_STAGE(PG8_SB(0, 0), cB, voffB); PG8_STAGE(PG8_SA(0, 0), cA, voffA); PG8_STAGE(PG8_SB(0, 1), cB + hstepB, voffB); PG8_STAGE(PG8_SA(0, 1), cA + hstepA, voffA);
    if (wr == 1) PG8_BAR;
    PG8_WAIT_V(4); PG8_BAR;
    PG8_STAGE(PG8_SB(1, 0), cB + kstep, voffB); PG8_STAGE(PG8_SA(1, 0), cA + kstep, voffA); PG8_STAGE(PG8_SB(1, 1), cB + hstepB + kstep, voffB);
    PG8_WAIT_V(6); PG8_BAR;
    PG8_STAMP();
    for (;;) {
        const bool has_next = S.next(ui + 1, nxt);
        const char* nA = has_next ? (const char*)g.A + (size_t)nxt.pm * tstepA : cA; const char* nB = has_next ? (const char*)g.Bt + (size_t)nxt.pn * tstepB : cB;
        for (int t = 0; t < nt; t += 2) {
            const bool last = (t == nt - 2);
            const char* a1 = cA + (size_t)(t + 1) * kstep;
            const char* a2 = last ? nA : cA + (size_t)(t + 2) * kstep; const char* b2 = last ? nB : cB + (size_t)(t + 2) * kstep;
            const char* a3 = a2 + kstep; const char* b3 = b2 + kstep;
            if (last && has_next) S.a_ready(nxt);
            PG8_LDB(B0, 0, 0); PG8_SCHED; PG8_LDA(At, 0, 0); PG8_STAGE(PG8_SA(1, 1), a1 + hstepA, voffA);
            PG8_WAIT_L(8); PG8_BAR; PG8_WAIT_L(0); PG8_MMA(0, 0, At, B0); PG8_BAR; PG8_SCHED;
            PG8_LDB(B1, 0, 1); PG8_STAGE(PG8_SB(0, 0), b2, voffB);
            PG8_BAR; PG8_WAIT_L(0); PG8_MMA(0, 1, At, B1); PG8_BAR;
            PG8_LDA(At, 0, 1); PG8_STAGE(PG8_SA(0, 0), a2, voffA);
            PG8_BAR; PG8_WAIT_L(0); PG8_MMA(1, 0, At, B0); PG8_BAR; PG8_SCHED;
            PG8_STAGE(PG8_SB(0, 1), b2 + hstepB, voffB);
            PG8_WAIT_V(6); PG8_BAR; PG8_MMA(1, 1, At, B1); PG8_BAR;
            PG8_LDB(B0, 1, 0); PG8_SCHED; PG8_LDA(At, 1, 0); PG8_STAGE(PG8_SA(0, 1), a2 + hstepA, voffA);
            PG8_WAIT_L(8); PG8_BAR; PG8_WAIT_L(0); PG8_MMA(0, 0, At, B0); PG8_BAR; PG8_SCHED;
            PG8_LDB(B1, 1, 1); PG8_STAGE(PG8_SB(1, 0), b3, voffB);
            PG8_BAR; PG8_WAIT_L(0); PG8_MMA(0, 1, At, B1); PG8_BAR;
            PG8_LDA(At, 1, 1); PG8_STAGE(PG8_SA(1, 0), a3, voffA);
            PG8_BAR; PG8_WAIT_L(0); PG8_MMA(1, 0, At, B0); PG8_BAR; PG8_SCHED;
            PG8_STAGE(PG8_SB(1, 1), b3 + hstepB, voffB);
            PG8_WAIT_V(6); PG8_BAR; PG8_MMA(1, 1, At, B1); PG8_BAR;
            if constexpr (Epi::KHOOK) { if (((t + 2) & 7) == 0) E.khook(acc, cur, ((t + 2) >> 3) - 1, wr, wc, fr, fq); }
        }
        PG8_STAMP();
        if constexpr (!Epi::AFTER_DRAIN) { E(acc, cur, wr, wc, fr, fq); S.done(cur); }
        PG8_STAMP();
        if (!has_next) break;
#pragma unroll
        for (int a = 0; a < 2; ++a)
#pragma unroll
            for (int b = 0; b < 2; ++b)
#pragma unroll
                for (int m = 0; m < 4; ++m)
#pragma unroll
                    for (int n = 0; n < 2; ++n) acc[a][b][m][n] = (f32x4){0.f, 0.f, 0.f, 0.f};
        cur = nxt; cA = nA; cB = nB; ++ui;
    }
    PG8_WAIT_V(0);
    if (wr == 0) PG8_BAR;
    PG8_BAR;
    if constexpr (Epi::AFTER_DRAIN) { E.fused(acc, cur, wr, wc, fr, fq, lds, wid, lane); S.done(cur); }
    PG8_STAMP();
    if (STAMP && wid == 0) { stamps[lane] = lane < nts ? (((unsigned long long)(unsigned)ts_hi << 32) | (unsigned)ts_lo) : 0ull;
        if (lane == 62) stamps[62] = rt_entry; if (lane == 63) stamps[63] = (unsigned long long)wall_clock64(); }
#undef PG8_STAMP
#undef PG8_SA
#undef PG8_SB
#undef PG8_STAGE
#undef PG8_LDA
#undef PG8_LDB
#undef PG8_MMA
#undef PG8_WAIT_V
#undef PG8_WAIT_L
#undef PG8_BAR
#undef PG8_SCHED
}
}

struct EpiProj0 {
  static constexpr bool PERM = true, AFTER_DRAIN = false, KHOOK = false;
  u16* O;
  DI void operator()(const f32x4 (&acc)[2][2][4][2], const pg8::Unit& u, int wr, int wc, int fr, int fq) const {
    const int row0 = u.pm * 256 + wr * 64 + fr;
#pragma unroll
    for (int ai = 0; ai < 2; ++ai)
#pragma unroll
      for (int m = 0; m < 4; ++m) {
        u16* rowp = O + (size_t)(row0 + ai * 128 + m * 16) * LD0;
#pragma unroll
        for (int bj = 0; bj < 2; ++bj) {
          const int colb = u.pn * 256 + bj * 128;
          f32x4 v0 = acc[ai][bj][m][0], v1 = acc[ai][bj][m][1];
          if (colb >= 512 && colb < 1536) {
#pragma unroll
            for (int e = 0; e < 4; ++e) { v0[e] = siluf_(v0[e]); v1[e] = siluf_(v1[e]); }
          }
          u32x4 w; w.x = pk2(v0[0], v0[1]); w.y = pk2(v0[2], v0[3]); w.z = pk2(v1[0], v1[1]); w.w = pk2(v1[2], v1[3]);
          *(u32x4*)(rowp + colb + wc * 32 + 8 * fq) = w;
        }
      }
  }
};
struct EpiProj1 {
  static constexpr bool PERM = true, AFTER_DRAIN = false, KHOOK = false;
  u16* Z; u16* X; u16* H; float* dt;
  DI void operator()(const f32x4 (&acc)[2][2][4][2], const pg8::Unit& u, int wr, int wc, int fr, int fq) const {
    const int row0 = u.pm * 256 + wr * 64 + fr;
#pragma unroll
    for (int ai = 0; ai < 2; ++ai)
#pragma unroll
      for (int m = 0; m < 4; ++m) {
        const int row = row0 + ai * 128 + m * 16;
#pragma unroll
        for (int bj = 0; bj < 2; ++bj) {
          const int colb = u.pn * 256 + bj * 128, col = colb + wc * 32 + 8 * fq;
          f32x4 v0 = acc[ai][bj][m][0], v1 = acc[ai][bj][m][1];
          if (colb < 2048) {
#pragma unroll
            for (int e = 0; e < 4; ++e) { v0[e] = siluf_(v0[e]); v1[e] = siluf_(v1[e]); }
            u32x4 w; w.x = pk2(v0[0], v0[1]); w.y = pk2(v0[2], v0[3]); w.z = pk2(v1[0], v1[1]); w.w = pk2(v1[2], v1[3]);
            *(u32x4*)(Z + (size_t)row * 2048 + col) = w;
          } else if (colb < 5120) {
            u32x4 w; w.x = pk2(v0[0], v0[1]); w.y = pk2(v0[2], v0[3]); w.z = pk2(v1[0], v1[1]); w.w = pk2(v1[2], v1[3]);
            *(u32x4*)(X + (size_t)row * 3072 + (col - 2048)) = w;
            if ((row & 31) >= 29) *(u32x4*)(H + ((size_t)(row >> 5) * 3 + ((row & 31) - 29)) * 3072 + (col - 2048)) = w;
          } else if (colb == 5120 && wc == 0) {
            *(f32x4*)(dt + (size_t)row * 32 + 8 * fq) = v0; *(f32x4*)(dt + (size_t)row * 32 + 8 * fq + 4) = v1;
          }
        }
      }
  }
};
template <bool HOOK> struct EpiResid {
  static constexpr bool PERM = false, AFTER_DRAIN = false, KHOOK = HOOK;
  const float* src; float* dst; const float* ss; char* lds_tbl;
  DI void khook(f32x4 (&acc)[2][2][4][2], const pg8::Unit& u, int g, int wr, int wc, int fr, int fq) const {
    PG8_LAS float* tbl = (PG8_LAS float*)lds_tbl;
    if (g == 0) {
      const int tid = tid_();
      if (tid < 256) {
        const f32x4 a = *(const f32x4*)(ss + (size_t)(u.pm * 256 + tid) * 4);
        asm volatile("s_waitcnt vmcnt(0)" ::: "memory");
        const float e0 = a[0] * (1.0f / 512.0f) + 1e-6f, e1 = a[1] * (1.0f / 512.0f) + 1e-6f, e2 = a[2] * (1.0f / 512.0f) + 1e-6f, e3 = a[3] * (1.0f / 512.0f) + 1e-6f;
        f32x4 rr; rr[0] = rsqrtf(e0) * sqrtf(e1); rr[1] = rsqrtf(e1) * sqrtf(e2); rr[2] = rsqrtf(e2) * sqrtf(e3); rr[3] = rsqrtf(e3);
        *(PG8_LAS f32x4*)(tbl + tid * 4) = rr;
      }
      asm volatile("s_waitcnt lgkmcnt(0)" ::: "memory");
      __builtin_amdgcn_s_barrier();
      asm volatile("" ::: "memory");
    }
#pragma unroll
    for (int ai = 0; ai < 2; ++ai)
#pragma unroll
      for (int m = 0; m < 4; ++m) {
        const float sc = tbl[(ai * 128 + wr * 64 + m * 16 + fr) * 4 + g];
#pragma unroll
        for (int bj = 0; bj < 2; ++bj)
#pragma unroll
          for (int n = 0; n < 2; ++n) acc[ai][bj][m][n] *= sc;
      }
  }
  DI void operator()(const f32x4 (&acc)[2][2][4][2], const pg8::Unit& u, int wr, int wc, int fr, int fq) const {
    const int row0 = u.pm * 256 + wr * 64 + fr, col0 = u.pn * 256 + wc * 32 + 4 * fq;
#pragma unroll
    for (int ai = 0; ai < 2; ++ai)
#pragma unroll
      for (int m = 0; m < 4; ++m) {
        const size_t ro = (size_t)(row0 + ai * 128 + m * 16) * 1024 + col0;
#pragma unroll
        for (int bj = 0; bj < 2; ++bj)
#pragma unroll
          for (int n = 0; n < 2; ++n) {
            const f32x4 xv = *(const f32x4*)(src + ro + bj * 128 + n * 16);
            *(f32x4*)(dst + ro + bj * 128 + n * 16) = xv * DN_ALPHA + acc[ai][bj][m][n];
          }
      }
  }
};
template <class Epi>
DI void pg8_run(const u16* A, int lda, const u16* Bt, int N, int K, const Epi& E, char* smem) {
  pg8::Gemm g; g.A = A; g.Bt = Bt; g.M = T; g.N = N; g.K = K; g.lda = lda;
  pg8::StaticOrder S; S.init(T, N, (int)gridDim.x, (int)blockIdx.x);
  pg8::gemm_phase<Epi, pg8::StaticOrder, false>((PG8_LAS unsigned char*)smem, g, S, E, nullptr);
  __syncthreads();
}

DI float neg_expm1(float x) {
  if (x > -0.1f) return -x * (1.0f + x * (0.5f + x * ((1.0f / 6.0f) + x * ((1.0f / 24.0f) + x * (1.0f / 120.0f)))));
  return 1.0f - fast_exp(x);
}
struct RgPre { u32x4 x[2][4]; };
DI void rglru_load(const Params& p, int item, RgPre& pre) {
  const int tid = tid_();
  const int hd = item & 7, bc = item >> 3, c = bc & 31, b = bc >> 5;
  const int t0 = b * SEQ + c * 128, s0 = c * 128;
  const u16* proj0 = (const u16*)(p.ws + OFF_PROJ0);
  const int ch = hd * 64 + (tid & 7) * 8;
#pragma unroll
  for (int i = 0; i < 2; ++i) {
    const int l = (tid >> 3) + 64 * i;
#pragma unroll
    for (int k = 0; k < 4; ++k) {
      u32x4 v = {0u, 0u, 0u, 0u};
      if (s0 + l - 3 + k >= 0) v = *(const u32x4*)(proj0 + (size_t)(t0 + l - 3 + k) * LD0 + ch);
      pre.x[i][k] = v;
    }
  }
}
DI void rglru_item(const Params& p, int item, int next_item, RgPre& pre, char* smem) {
  char* ws = p.ws;
  const int hd = item & 7, bc = item >> 3, c = bc & 31, b = bc >> 5;
  const int t0 = b * SEQ + c * 128;
  u16* Xc = (u16*)smem;
  u16* Was = (u16*)(smem + 18432);
  u16* Wxs = (u16*)(smem + 18432 + 9216);
  float* Xf = (float*)(smem + 36864);
  float* tend = (float*)(smem + 36864 + 33280);
  const int tid = tid_(), lane = tid & 63, w = tid >> 6, r = lane & 31, h = lane >> 5;
  {
    const int cc = (tid & 7) * 8, ch = hd * 64 + cc;
    float cw[4][8], cb[8];
#pragma unroll
    for (int k = 0; k < 4; ++k) {
      const f32x4 a = *(const f32x4*)(p.ab_conv_w + k * 512 + ch), bq = *(const f32x4*)(p.ab_conv_w + k * 512 + ch + 4);
      cw[k][0] = a[0]; cw[k][1] = a[1]; cw[k][2] = a[2]; cw[k][3] = a[3]; cw[k][4] = bq[0]; cw[k][5] = bq[1]; cw[k][6] = bq[2]; cw[k][7] = bq[3];
    }
    { const f32x4 a = *(const f32x4*)(p.ab_conv_b + ch), bq = *(const f32x4*)(p.ab_conv_b + ch + 4);
      cb[0] = a[0]; cb[1] = a[1]; cb[2] = a[2]; cb[3] = a[3]; cb[4] = bq[0]; cb[5] = bq[1]; cb[6] = bq[2]; cb[7] = bq[3]; }
#pragma unroll
    for (int i = 0; i < 2; ++i) {
      const int l = (tid >> 3) + 64 * i;
      float xc[8];
#pragma unroll
      for (int e = 0; e < 8; ++e) xc[e] = cb[e];
#pragma unroll
      for (int k = 0; k < 4; ++k) {
        float f[8]; unpack8(pre.x[i][k], f);
#pragma unroll
        for (int e = 0; e < 8; ++e) xc[e] += cw[k][e] * f[e];
      }
      *(u32x4*)(Xc + l * GA_ST + cc) = pack8(xc);
#pragma unroll
      for (int e = 0; e < 8; ++e) Xf[l * 65 + cc + e] = xc[e];
    }
    const int j = tid >> 3;
    *(u32x4*)(Was + j * GA_ST + cc) = *(const u32x4*)((const u16*)(ws + OFF_WAT) + hd * 4096 + j * 64 + cc);
    *(u32x4*)(Wxs + j * GA_ST + cc) = *(const u32x4*)((const u16*)(ws + OFF_WXT) + hd * 4096 + j * 64 + cc);
  }
  __syncthreads();
  if (next_item >= 0) rglru_load(p, next_item, pre);
  const int lt = w & 3, jt = w >> 2, j = jt * 32 + r, chg = hd * 64 + j;
  f32x16 accA, accX;
#pragma unroll
  for (int e = 0; e < 16; ++e) { accA[e] = 0.f; accX[e] = 0.f; }
#pragma unroll
  for (int ks = 0; ks < 4; ++ks) {
    const bf16x8 af = ld_frag16(Xc + (lt * 32 + r) * GA_ST + ks * 16 + h * 8);
    const bf16x8 ba = ld_frag16(Was + (jt * 32 + r) * GA_ST + ks * 16 + h * 8);
    const bf16x8 bx = ld_frag16(Wxs + (jt * 32 + r) * GA_ST + ks * 16 + h * 8);
    accA = MFMA32(af, ba, accA); accX = MFMA32(af, bx, accX);
  }
  const float gab = p.ga_b[chg], gxb = p.gx_b[chg], sp8 = -8.0f * ((const float*)(ws + OFF_SP))[chg];
  float Av[16], Bv[16];
#pragma unroll
  for (int i = 0; i < 16; ++i) {
    const float ra_ = sigmoidf_(accA[i] + gab);
    const float ix = sigmoidf_(accX[i] + gxb);
    const float log_a = sp8 * ra_;
    Av[i] = fast_exp(log_a);
    const float mult = sqrtf(neg_expm1(2.0f * log_a));
    Bv[i] = mult * ix * Xf[(lt * 32 + crow(i, h)) * 65 + j];
  }
#pragma unroll
  for (int q = 0; q < 4; ++q)
#pragma unroll
    for (int e = 1; e < 4; ++e) { Bv[4 * q + e] = Av[4 * q + e] * Bv[4 * q + e - 1] + Bv[4 * q + e]; Av[4 * q + e] = Av[4 * q + e] * Av[4 * q + e - 1]; }
  float Ho[4], Po[4];
  {
    float H = 0.f, P = 1.f;
#pragma unroll
    for (int q = 0; q < 4; ++q) {
      const float Am = Av[4 * q + 3], Bm = Bv[4 * q + 3];
      const float Ap = __shfl_xor(Am, 32), Bp = __shfl_xor(Bm, 32);
      const float A0 = h ? Ap : Am, B0 = h ? Bp : Bm, A1 = h ? Am : Ap, B1 = h ? Bm : Bp;
      if (h == 0) { Ho[q] = H; Po[q] = P; }
      H = A0 * H + B0; P = P * A0;
      if (h == 1) { Ho[q] = H; Po[q] = P; }
      H = A1 * H + B1; P = P * A1;
    }
    if (h == 1) { tend[(lt * 64 + j) * 2] = P; tend[(lt * 64 + j) * 2 + 1] = H; }
  }
  __syncthreads();
  float Hc = 0.f, Pp = 1.f;
  for (int tp = 0; tp < lt; ++tp) { const float Pe = tend[(tp * 64 + j) * 2], He = tend[(tp * 64 + j) * 2 + 1]; Hc = Pe * Hc + He; Pp *= Pe; }
  unsigned* hp = (unsigned*)(ws + OFF_HLOC) + (size_t)(t0 + lt * 32) * 512 + chg;
  float hlast = 0.f, plast = 0.f;
#pragma unroll
  for (int i = 0; i < 16; ++i) {
    const int q = i >> 2;
    const float hin = Ho[q] + Po[q] * Hc, pin = Po[q] * Pp;
    const float hv = Bv[i] + Av[i] * hin, pv = Av[i] * pin;
    hp[(size_t)crow(i, h) * 512] = pk2(hv, pv);
    hlast = hv; plast = pv;
  }
  if (lt == 3 && h == 1) {
    ((float*)(ws + OFF_HEND))[(size_t)(b * 32 + c) * 512 + chg] = hlast;
    ((float*)(ws + OFF_PEND))[(size_t)(b * 32 + c) * 512 + chg] = plast;
  }
  __syncthreads();
}

DI void krope_item(const Params& p, int item) {
  char* ws = p.ws;
  const u16* proj0 = (const u16*)(ws + OFF_PROJ0);
  const float* ct = (const float*)(ws + OFF_COS); const float* st = (const float*)(ws + OFF_SIN);
  u16* kc = (u16*)(ws + OFF_KC);
#pragma unroll
  for (int i = 0; i < 8; ++i) {
    const int u = tid_() + NT * i, tl = u >> 4, j = u & 15, t = item * 256 + tl;
    const float x1 = bf2f(proj0[(size_t)t * LD0 + 1920 + j]), x2 = bf2f(proj0[(size_t)t * LD0 + 1936 + j]);
    const float c = ct[(size_t)t * 16 + j], s = st[(size_t)t * 16 + j];
    const u16 o1 = f2bf(x1 * c - x2 * s), o2 = f2bf(x2 * c + x1 * s);
#pragma unroll
    for (int hh = 0; hh < 8; ++hh) { kc[(size_t)t * 768 + hh * 96 + 64 + j] = o1; kc[(size_t)t * 768 + hh * 96 + 80 + j] = o2; }
  }
}

constexpr int KS_ST = 104, VS_ST = 72;
DI void attn_item(const Params& p, int bh, int qb, char* smem) {
  char* ws = p.ws;
  const int b = bh >> 3, hh = bh & 7;
  u16* Ks = (u16*)smem;
  u16* Vs = (u16*)(smem + 2 * 64 * KS_ST * 2);
  const int tid = tid_(), lane = tid & 63, w = tid >> 6, r = lane & 31, h = lane >> 5;
  const int q0 = qb * 256, qw = q0 + w * 32, sq = qw + r;
  const size_t t = (size_t)b * SEQ + sq;
  const u16* Q = (const u16*)(ws + OFF_Q);
  const u16* Kc = (const u16*)(ws + OFF_KC) + (size_t)b * SEQ * 768 + hh * 96;
  const u16* Vt = (const u16*)(ws + OFF_VT) + (size_t)bh * 64 * SEQ;
  bf16x8 qf[6];
#pragma unroll
  for (int s = 0; s < 6; ++s) qf[s] = ld_frag16(Q + t * 768 + hh * 96 + s * 16 + h * 8);
  f32x16 o0, o1;
#pragma unroll
  for (int e = 0; e < 16; ++e) { o0[e] = 0.f; o1[e] = 0.f; }
  float m = -1e30f, l = 0.f;
  const int nkt = 4 * (qb + 1);
  const int c0 = tid, c1 = tid + NT;
  const int kr0 = c0 / 12, kc0 = (c0 % 12) * 8, kr1 = c1 / 12, kc1 = (c1 % 12) * 8;
  const bool has1 = c1 < 768;
  const int vd = tid >> 3, vk = (tid & 7) * 8;
  u32x4 rk0, rk1, rv;
  auto gload = [&](int kt) {
    const int k0 = kt * 64;
    rk0 = *(const u32x4*)(Kc + (size_t)(k0 + kr0) * 768 + kc0);
    if (has1) rk1 = *(const u32x4*)(Kc + (size_t)(k0 + kr1) * 768 + kc1);
    rv = *(const u32x4*)(Vt + (size_t)vd * SEQ + k0 + vk);
  };
  auto lstore = [&](int buf) {
    u16* ks = Ks + buf * 64 * KS_ST; u16* vs = Vs + buf * 64 * VS_ST;
    *(u32x4*)(ks + kr0 * KS_ST + kc0) = rk0;
    if (has1) *(u32x4*)(ks + kr1 * KS_ST + kc1) = rk1;
    *(u32x4*)(vs + vd * VS_ST + vk) = rv;
  };
  gload(0); lstore(0);
  __syncthreads();
  for (int kt = 0; kt < nkt; ++kt) {
    const int buf = kt & 1, k0 = kt * 64;
    if (kt + 1 < nkt) gload(kt + 1);
    if (k0 <= qw + 31) {
      const u16* ks = Ks + buf * 64 * KS_ST; const u16* vs = Vs + buf * 64 * VS_ST;
      f32x16 st0, st1;
#pragma unroll
      for (int e = 0; e < 16; ++e) { st0[e] = 0.f; st1[e] = 0.f; }
#pragma unroll
      for (int s = 0; s < 6; ++s) {
        const bf16x8 k0f = ld_frag16(ks + r * KS_ST + s * 16 + h * 8);
        const bf16x8 k1f = ld_frag16(ks + (32 + r) * KS_ST + s * 16 + h * 8);
        st0 = MFMA32(k0f, qf[s], st0); st1 = MFMA32(k1f, qf[s], st1);
      }
      if (k0 + 63 > qw) {
#pragma unroll
        for (int i = 0; i < 16; ++i) {
          const int key = k0 + crow(i, h);
          if (key > sq) st0[i] = -1e30f;
          if (key + 32 > sq) st1[i] = -1e30f;
        }
      }
      float mx = st0[0];
#pragma unroll
      for (int i = 1; i < 16; ++i) mx = fmaxf(mx, st0[i]);
#pragma unroll
      for (int i = 0; i < 16; ++i) mx = fmaxf(mx, st1[i]);
      mx = fmaxf(mx, __shfl_xor(mx, 32));
      const float mn = fmaxf(m, mx), alpha = fast_exp2(m - mn);
      float ls = 0.f;
#pragma unroll
      for (int i = 0; i < 16; ++i) { st0[i] = fast_exp2(st0[i] - mn); st1[i] = fast_exp2(st1[i] - mn); ls += st0[i] + st1[i]; }
      l = l * alpha + ls; m = mn;
#pragma unroll
      for (int e = 0; e < 16; ++e) { o0[e] *= alpha; o1[e] *= alpha; }
#pragma unroll
      for (int s = 0; s < 2; ++s) {
        const bf16x8 p0 = pack_frag(st0, s), p1 = pack_frag(st1, s);
        {
          const u16* v0 = vs + r * VS_ST + 16 * s + 4 * h;
          const bf16x8 va = ld_frag8x2(v0, v0 + 8), vb = ld_frag8x2(v0 + 32 * VS_ST, v0 + 32 * VS_ST + 8);
          o0 = MFMA32(va, p0, o0); o1 = MFMA32(vb, p0, o1);
        }
        {
          const u16* v1 = vs + r * VS_ST + 32 + 16 * s + 4 * h;
          const bf16x8 va = ld_frag8x2(v1, v1 + 8), vb = ld_frag8x2(v1 + 32 * VS_ST, v1 + 32 * VS_ST + 8);
          o0 = MFMA32(va, p1, o0); o1 = MFMA32(vb, p1, o1);
        }
      }
    }
    if (kt + 1 < nkt) lstore(buf ^ 1);
    __syncthreads();
  }
  const float lt = l + __shfl_xor(l, 32), inv = 1.0f / lt;
  const u16* sg = (const u16*)(ws + OFF_PROJ0) + t * LD0 + 1024 + hh * 64;
  u16* yc = (u16*)(ws + OFF_YCAT) + t * 1024 + 512 + hh * 64;
#pragma unroll
  for (int dt = 0; dt < 2; ++dt)
#pragma unroll
    for (int g = 0; g < 4; ++g) {
      const int d = dt * 32 + 8 * g + 4 * h;
      const u32x2 gv = *(const u32x2*)(sg + d);
      const f32x16& o = dt ? o1 : o0;
      u32x2 ov;
      ov.x = pk2(o[4 * g] * inv * bflo(gv.x), o[4 * g + 1] * inv * bfhi(gv.x));
      ov.y = pk2(o[4 * g + 2] * inv * bflo(gv.y), o[4 * g + 3] * inv * bfhi(gv.y));
      *(u32x2*)(yc + d) = ov;
    }
}

DI void fixup_item(const Params& p, int item, char* smem) {
  char* ws = p.ws;
  const int b = item >> 5, c = item & 31, tid = tid_();
  float* Hin = (float*)smem;
  {
    const float* he = (const float*)(ws + OFF_HEND) + (size_t)(b * 32) * 512 + tid;
    const float* pe = (const float*)(ws + OFF_PEND) + (size_t)(b * 32) * 512 + tid;
    float H = 0.f;
    int cp = 0;
    for (; cp + 8 <= c; cp += 8) {
      float pv[8], hv[8];
#pragma unroll
      for (int k = 0; k < 8; ++k) { pv[k] = pe[(cp + k) * 512]; hv[k] = he[(cp + k) * 512]; }
#pragma unroll
      for (int k = 0; k < 8; ++k) H = pv[k] * H + hv[k];
    }
    for (; cp < c; ++cp) H = pe[cp * 512] * H + he[cp * 512];
    Hin[tid] = H;
  }
  __syncthreads();
  const size_t t0 = (size_t)b * SEQ + c * 128;
  const unsigned* hp = (const unsigned*)(ws + OFF_HLOC);
  const u16* proj0 = (const u16*)(ws + OFF_PROJ0); u16* yc = (u16*)(ws + OFF_YCAT);
#pragma unroll 4
  for (int i = 0; i < 16; ++i) {
    const int u = tid + NT * i, l = u >> 6, cc = (u & 63) * 8;
    const size_t tt = t0 + l;
    const u32x4 ha = *(const u32x4*)(hp + tt * 512 + cc), hb = *(const u32x4*)(hp + tt * 512 + cc + 4), gv = *(const u32x4*)(proj0 + tt * LD0 + 512 + cc);
    float gf[8], o[8];
    unpack8(gv, gf);
    const unsigned hw[8] = {ha.x, ha.y, ha.z, ha.w, hb.x, hb.y, hb.z, hb.w};
#pragma unroll
    for (int e = 0; e < 8; ++e) o[e] = (bflo(hw[e]) + bfhi(hw[e]) * Hin[cc + e]) * gf[e];
    *(u32x4*)(yc + tt * 1024 + cc) = pack8(o);
  }
  __syncthreads();
}

DI void ln_phase(const Params& p, const float* __restrict__ g, const float* __restrict__ bta, u16* xb) {
  const int lane = tid_() & 63, gw = blockIdx.x * 8 + (tid_() >> 6), nw = gridDim.x * 8;
  f32x4 gg[4], bb[4];
#pragma unroll
  for (int i = 0; i < 4; ++i) { gg[i] = *(const f32x4*)(g + i * 256 + lane * 4); bb[i] = *(const f32x4*)(bta + i * 256 + lane * 4); }
  f32x4 nx[4];
  if (gw < T) {
#pragma unroll
    for (int i = 0; i < 4; ++i) nx[i] = *(const f32x4*)(p.out + (size_t)gw * 1024 + i * 256 + lane * 4);
  }
  for (int row = gw; row < T; row += nw) {
    float* pr = p.out + (size_t)row * 1024;
    f32x4 v[4];
#pragma unroll
    for (int i = 0; i < 4; ++i) v[i] = nx[i];
    if (row + nw < T) {
#pragma unroll
      for (int i = 0; i < 4; ++i) nx[i] = *(const f32x4*)(pr + (size_t)nw * 1024 + i * 256 + lane * 4);
    }
    float s = 0.f;
#pragma unroll
    for (int i = 0; i < 4; ++i) s += (v[i].x + v[i].y) + (v[i].z + v[i].w);
#pragma unroll
    for (int d = 1; d < 64; d <<= 1) s += __shfl_xor(s, d);
    const float mu = s * (1.0f / 1024.0f);
    float q = 0.f;
#pragma unroll
    for (int i = 0; i < 4; ++i) { v[i].x -= mu; v[i].y -= mu; v[i].z -= mu; v[i].w -= mu; q += (v[i].x * v[i].x + v[i].y * v[i].y) + (v[i].z * v[i].z + v[i].w * v[i].w); }
#pragma unroll
    for (int d = 1; d < 64; d <<= 1) q += __shfl_xor(q, d);
    const float rstd = rsqrtf(q * (1.0f / 1024.0f) + 1e-5f);
#pragma unroll
    for (int i = 0; i < 4; ++i) {
      f32x4 o;
      o.x = v[i].x * rstd * gg[i].x + bb[i].x; o.y = v[i].y * rstd * gg[i].y + bb[i].y; o.z = v[i].z * rstd * gg[i].z + bb[i].z; o.w = v[i].w * rstd * gg[i].w + bb[i].w;
      *(f32x4*)(pr + i * 256 + lane * 4) = o;
      if (xb) { u32x2 w; w.x = pk2(o.x, o.y); w.y = pk2(o.z, o.w); *(u32x2*)(xb + (size_t)row * 1024 + i * 256 + lane * 4) = w; }
    }
  }
}

DI void ssdprep_phase(const Params& p) {
  char* ws = p.ws;
  const int tid = tid_(), lane = tid & 63;
  {
    float* dtb = (float*)(ws + OFF_DT); float* csb = (float*)(ws + OFF_CS);
    const int gw = blockIdx.x * 8 + (tid >> 6), nw = gridDim.x * 8;
    for (int it = gw; it < 8192; it += nw) {
      const int hd = it & 31, bc = it >> 5;
      const size_t t0 = (size_t)bc * 128;
      const float a_neg = -expf(p.a_log[hd]), dtbias = p.dt_bias[hd];
      const float r0 = dtb[(t0 + 2 * lane) * 32 + hd] + dtbias, r1 = dtb[(t0 + 2 * lane + 1) * 32 + hd] + dtbias;
      const float d0 = fmaxf(r0, 0.f) + log1pf(expf(-fabsf(r0))), d1 = fmaxf(r1, 0.f) + log1pf(expf(-fabsf(r1)));
      const float a0 = d0 * a_neg, a1 = d1 * a_neg;
      float s = a0 + a1;
#pragma unroll
      for (int d = 1; d < 64; d <<= 1) { const float o = __shfl_up(s, d, 64); if (lane >= d) s += o; }
      dtb[(t0 + 2 * lane) * 32 + hd] = d0; dtb[(t0 + 2 * lane + 1) * 32 + hd] = d1;
      csb[(t0 + 2 * lane) * 32 + hd] = s - a1; csb[(t0 + 2 * lane + 1) * 32 + hd] = s;
    }
  }
  {
    u16* X = (u16*)(ws + OFF_XBC); const u16* H = (const u16*)(ws + OFF_HALO);
    const size_t gid = (size_t)blockIdx.x * NT + tid, gstride = (size_t)gridDim.x * NT;
    for (size_t task = gid; task < (size_t)1024 * 384; task += gstride) {
      const int cg = (int)(task % 384), rt = (int)(task / 384), ch = cg * 8;
      float cw[4][8], cb[8];
#pragma unroll
      for (int k = 0; k < 4; ++k)
#pragma unroll
        for (int e = 0; e < 8; ++e) cw[k][e] = p.ssd_conv_w[k * 3072 + ch + e];
#pragma unroll
      for (int e = 0; e < 8; ++e) cb[e] = p.ssd_conv_b[ch + e];
      float w0[8], w1[8], w2[8];
      if ((rt & 127) == 0) {
#pragma unroll
        for (int e = 0; e < 8; ++e) { w0[e] = 0.f; w1[e] = 0.f; w2[e] = 0.f; }
      } else {
        const u16* hp = H + (size_t)(rt - 1) * 3 * 3072 + ch;
        unpack8(*(const u32x4*)(hp), w0); unpack8(*(const u32x4*)(hp + 3072), w1); unpack8(*(const u32x4*)(hp + 2 * 3072), w2);
      }
      u16* xp = X + (size_t)rt * 32 * 3072 + ch;
      for (int r8 = 0; r8 < 32; r8 += 8) {
        u32x4 raw[8];
#pragma unroll
        for (int i = 0; i < 8; ++i) raw[i] = *(const u32x4*)(xp + (size_t)(r8 + i) * 3072);
#pragma unroll
        for (int i = 0; i < 8; ++i) {
          float f[8], o[8]; unpack8(raw[i], f);
#pragma unroll
          for (int e = 0; e < 8; ++e) {
            o[e] = siluf_(cb[e] + cw[0][e] * w0[e] + cw[1][e] * w1[e] + cw[2][e] * w2[e] + cw[3][e] * f[e]);
            w0[e] = w1[e]; w1[e] = w2[e]; w2[e] = f[e];
          }
          *(u32x4*)(xp + (size_t)(r8 + i) * 3072) = pack8(o);
        }
      }
    }
  }
}

DI void ygscale_phase(const Params& p) {
  char* ws = p.ws;
  u16* yg = (u16*)(ws + OFF_Z); const float* ss = (const float*)(ws + OFF_SS);
  const size_t gid = (size_t)blockIdx.x * NT + tid_(), gstride = (size_t)gridDim.x * NT;
  for (size_t u = gid; u < (size_t)T * 256; u += gstride) {
    const size_t t = u >> 8; const int c8 = (int)(u & 255) * 8;
    const float rs = rsqrtf(ss[t * 4 + (c8 >> 9)] * (1.0f / 512.0f) + 1e-6f);
    u32x4* ptr = (u32x4*)(yg + t * 2048 + c8);
    float f[8]; unpack8(*ptr, f);
#pragma unroll
    for (int e = 0; e < 8; ++e) f[e] *= rs;
    *ptr = pack8(f);
  }
}

#define LAS3 __attribute__((address_space(3)))
DI unsigned off_b(unsigned row, unsigned ch) { return 256u * row + 16u * (ch ^ (((row & 3) << 2) | ((row >> 2) & 3))); }
DI unsigned tr_addr(int lane, unsigned row0, unsigned c) {
  const unsigned blk = (lane >> 4) & 1, q = (lane & 15) >> 2, pp = lane & 3;
  return off_b(row0 + q, 4 * c + 2 * blk + (pp >> 1)) + 8 * (pp & 1);
}
DI s16x4 tr_read(const char* img, unsigned off) { return __builtin_amdgcn_ds_read_tr16_b64_v4i16((LAS3 s16x4*)(img + off)); }
DI bf16x8 tr_frag(const char* img, unsigned o0, unsigned o1) {
  const s16x4 lo = tr_read(img, o0), hi = tr_read(img, o1);
  return __builtin_shufflevector(lo, hi, 0, 1, 2, 3, 4, 5, 6, 7);
}
constexpr int SS_ST = 136;
DI void ssd_item(const Params& p, int item, char* smem) {
  char* ws = p.ws;
  const int b = item >> 5, hd = item & 31, g = hd >> 3;
  char* Bs = smem;
  char* Xs = smem + 32768;
  char* Xw = smem + 2 * 32768;
  u16* Cs = (u16*)(smem + 3 * 32768);
  u16* St = (u16*)(smem + 3 * 32768 + 34816);
  float* cs = (float*)(smem + 3 * 32768 + 34816 + 17408);
  float* dts = cs + 128;
  const int tid = tid_(), lane = tid & 63, w = tid >> 6, r = lane & 31, h = lane >> 5;
  const float Dh = p.ssd_d[hd];
  u16* Zb = (u16*)(ws + OFF_Z);
  const u16* Xg = (const u16*)(ws + OFF_XBC);
  const float* dtb = (const float*)(ws + OFF_DT);
  const float* csb = (const float*)(ws + OFF_CS);
  float* ssb = (float*)(ws + OFF_SS);
  const int xch = tid & 7, xl = tid >> 3;
  const int bch = tid & 15, bl = tid >> 4;
  f32x16 stacc;
#pragma unroll
  for (int e = 0; e < 16; ++e) stacc[e] = 0.f;
  for (int i = tid; i < 64 * SS_ST / 2; i += NT) ((unsigned*)St)[i] = 0u;
  const int lt = (w < 4) ? w : 7 - w, pt = w >> 2, nt = w & 3;
  u32x4 px[2], pb[4], pc[4];
  float pdt[2], pcx[2], pcsT, pcl;
  auto prefetch = [&](int c) {
    const size_t t0 = (size_t)b * SEQ + c * 128;
#pragma unroll
    for (int i = 0; i < 2; ++i) {
      px[i] = *(const u32x4*)(Xg + (t0 + xl + 64 * i) * 3072 + hd * 64 + xch * 8);
      pdt[i] = dtb[(t0 + xl + 64 * i) * 32 + hd];
      pcx[i] = csb[(t0 + xl + 64 * i) * 32 + hd];
    }
#pragma unroll
    for (int i = 0; i < 4; ++i) {
      pb[i] = *(const u32x4*)(Xg + (t0 + bl + 32 * i) * 3072 + 2048 + g * 128 + bch * 8);
      pc[i] = *(const u32x4*)(Xg + (t0 + bl + 32 * i) * 3072 + 2560 + g * 128 + bch * 8);
    }
    pcsT = csb[(t0 + 127) * 32 + hd];
    pcl = (tid < 128) ? csb[(t0 + tid) * 32 + hd] : dtb[(t0 + (tid & 127)) * 32 + hd];
  };
  prefetch(0);
  for (int c = 0; c < 32; ++c) {
    const size_t t0 = (size_t)b * SEQ + c * 128;
    const float csT = pcsT;
    if (tid < 256) cs[tid] = pcl;
#pragma unroll
    for (int i = 0; i < 2; ++i) {
      const int l = xl + 64 * i;
      *(u32x4*)(Xs + off_b(l, xch)) = px[i];
      const float sc = pdt[i] * fast_exp(csT - pcx[i]);
      float f[8]; unpack8(px[i], f);
#pragma unroll
      for (int e = 0; e < 8; ++e) f[e] *= sc;
      *(u32x4*)(Xw + off_b(l, xch)) = pack8(f);
    }
#pragma unroll
    for (int i = 0; i < 4; ++i) {
      const int l = bl + 32 * i;
      *(u32x4*)(Bs + off_b(l, bch)) = pb[i];
      *(u32x4*)(Cs + l * SS_ST + bch * 8) = pc[i];
    }
    __syncthreads();
    {
      const int l = lt * 32 + r;
      const size_t t = t0 + l;
      u16* zrow = Zb + t * 2048 + hd * 64;
      u32x2 zv[4];
#pragma unroll
      for (int gq = 0; gq < 4; ++gq) zv[gq] = *(const u32x2*)(zrow + pt * 32 + 8 * gq + 4 * h);
      if (c + 1 < 32) prefetch(c + 1);
      const float csl = cs[l];
      f32x16 yd;
#pragma unroll
      for (int e = 0; e < 16; ++e) yd[e] = 0.f;
#pragma unroll
      for (int ks = 0; ks < 8; ++ks) {
        const bf16x8 sf = ld_frag16(St + (pt * 32 + r) * SS_ST + ks * 16 + h * 8);
        const bf16x8 cf = ld_frag16(Cs + l * SS_ST + ks * 16 + h * 8);
        yd = MFMA32(sf, cf, yd);
      }
      {
        const float el = fast_exp(csl);
#pragma unroll
        for (int e = 0; e < 16; ++e) yd[e] *= el;
      }
      for (int st = 0; st <= lt; ++st) {
        f32x16 cb_;
#pragma unroll
        for (int e = 0; e < 16; ++e) cb_[e] = 0.f;
#pragma unroll
        for (int ks = 0; ks < 8; ++ks) {
          const bf16x8 bf = *(const bf16x8*)(Bs + off_b(st * 32 + r, 2 * ks + h));
          const bf16x8 cf = ld_frag16(Cs + l * SS_ST + ks * 16 + h * 8);
          cb_ = MFMA32(bf, cf, cb_);
        }
        {
          const int lim = l - st * 32;
#pragma unroll
          for (int gq = 0; gq < 4; ++gq) {
            const f32x4 cs4 = *(const f32x4*)(cs + st * 32 + 8 * gq + 4 * h), dt4 = *(const f32x4*)(dts + st * 32 + 8 * gq + 4 * h);
#pragma unroll
            for (int e = 0; e < 4; ++e) {
              const float v = cb_[4 * gq + e] * fast_exp(fminf(csl - cs4[e], 0.f)) * dt4[e];
              cb_[4 * gq + e] = (8 * gq + 4 * h + e <= lim) ? v : 0.f;
            }
          }
        }
#pragma unroll
        for (int s2 = 0; s2 < 2; ++s2) {
          const bf16x8 pf = pack_frag(cb_, s2);
          const unsigned row0 = st * 32 + 16 * s2 + 4 * h;
          const bf16x8 xf = tr_frag(Xs, tr_addr(lane, row0, pt), tr_addr(lane, row0 + 8, pt));
          yd = MFMA32(xf, pf, yd);
        }
      }
      float ssq = 0.f;
#pragma unroll
      for (int gq = 0; gq < 4; ++gq) {
        const int pb_ = pt * 32 + 8 * gq + 4 * h;
        const u32x2 xv = *(const u32x2*)(Xs + off_b(l, pb_ >> 3) + (pb_ & 7) * 2);
        const float y0 = (yd[4 * gq] + Dh * bflo(xv.x)) * bflo(zv[gq].x);
        const float y1 = (yd[4 * gq + 1] + Dh * bfhi(xv.x)) * bfhi(zv[gq].x);
        const float y2 = (yd[4 * gq + 2] + Dh * bflo(xv.y)) * bflo(zv[gq].y);
        const float y3 = (yd[4 * gq + 3] + Dh * bfhi(xv.y)) * bfhi(zv[gq].y);
        ssq += (y0 * y0 + y1 * y1) + (y2 * y2 + y3 * y3);
        u32x2 ov; ov.x = pk2(y0, y1); ov.y = pk2(y2, y3);
        *(u32x2*)(zrow + pb_) = ov;
      }
      ssq += __shfl_xor(ssq, 32);
      if (h == 0) atomicAdd(ssb + t * 4 + g, ssq);
    }
    {
      const float dT = fast_exp(csT);
#pragma unroll
      for (int e = 0; e < 16; ++e) stacc[e] *= dT;
#pragma unroll
      for (int ks = 0; ks < 8; ++ks) {
        const unsigned row0 = 16 * ks + 8 * h;
        const bf16x8 bf = tr_frag(Bs, tr_addr(lane, row0, nt), tr_addr(lane, row0 + 4, nt));
        const bf16x8 xf = tr_frag(Xw, tr_addr(lane, row0, pt), tr_addr(lane, row0 + 4, pt));
        stacc = MFMA32(bf, xf, stacc);
      }
    }
    __syncthreads();
#pragma unroll
    for (int gq = 0; gq < 4; ++gq) {
      u32x2 ov; ov.x = pk2(stacc[4 * gq], stacc[4 * gq + 1]); ov.y = pk2(stacc[4 * gq + 2], stacc[4 * gq + 3]);
      *(u32x2*)(St + (pt * 32 + r) * SS_ST + nt * 32 + 8 * gq + 4 * h) = ov;
    }
  }
  __syncthreads();
}

#define XB_TMO      128
#define XB_XCNT(j)  (256  + 64 * (j))
#define XB_XSUB(j)  (1280 + 64 * (j))
#define XB_XGEN(j)  (2304 + 64 * (j))
#define XB_TOP      3328
#define XB_TOPGEN   3392
#define XCD_BAR_WORDS 3456
#define XB_SPIN_CAP (1u << 18)
#define XLAS __attribute__((address_space(3)))

__device__ __forceinline__ unsigned xb_ld(unsigned* p)              { return __hip_atomic_load(p, __ATOMIC_RELAXED, __HIP_MEMORY_SCOPE_AGENT); }
__device__ __forceinline__ unsigned xb_add(unsigned* p, unsigned v) { return __hip_atomic_fetch_add(p, v, __ATOMIC_RELAXED, __HIP_MEMORY_SCOPE_AGENT); }
__device__ __forceinline__ unsigned xb_xcc_id() { return (unsigned)__builtin_amdgcn_s_getreg((3 << 11) | 20) & 0xFu; }
#define XB_SPIN(cond, bar) do { unsigned _sp = 0; while (cond) { __builtin_amdgcn_s_sleep(1); \
    if ((++_sp & 255u) == 0u) { if (xb_ld(&(bar)[XB_TMO])) break; if (_sp > XB_SPIN_CAP) { atomicAdd(&(bar)[XB_TMO], 1u); break; } } } } while (0)

struct XcdBarrier {
    unsigned* bar; unsigned x;
    volatile XLAS unsigned* st;
};

__device__ __forceinline__ XcdBarrier xcd_barrier_post(unsigned* bar, volatile XLAS unsigned* st) {
    XcdBarrier b; b.bar = bar; b.x = xb_xcc_id(); b.st = st;
    if (tid_() == 0) (void)xb_add(&bar[XB_XCNT(b.x)], 1u);
    return b;
}
__device__ __forceinline__ void xcd_barrier_complete(unsigned* bar, unsigned x, unsigned& nloc, unsigned& nx) {
    const unsigned G = gridDim.x * gridDim.y * gridDim.z;
    unsigned sum, cnt, mine, sp = 0u;
    for (;;) {
        sum = 0u; cnt = 0u; mine = 0u;
#pragma unroll
        for (unsigned j = 0; j < 16; ++j) { const unsigned c = xb_ld(&bar[XB_XCNT(j)]); sum += c; cnt += (c > 0u) ? 1u : 0u; mine = (j == x) ? c : mine; }
        if (sum == G) break;
        __builtin_amdgcn_s_sleep(1);
        if ((++sp & 255u) == 0u) { if (xb_ld(&bar[XB_TMO])) break; if (sp > XB_SPIN_CAP) { atomicAdd(&bar[XB_TMO], 1u); break; } }
    }
    nloc = mine > 0u ? mine : 1u; nx = cnt > 0u ? cnt : 1u;
}

__device__ __forceinline__ void xcd_barrier(const XcdBarrier& b) {
    asm volatile("s_waitcnt vmcnt(0)" ::: "memory");
    __syncthreads();
    if (tid_() == 0) {
        unsigned* bar = b.bar;
        __builtin_amdgcn_s_waitcnt(0);
        unsigned nloc = b.st[0], nx = b.st[1];
        if (nloc == 0u) { xcd_barrier_complete(bar, b.x, nloc, nx); b.st[0] = nloc; b.st[1] = nx; }
        const unsigned old = xb_add(&bar[XB_XSUB(b.x)], 1u);
        const unsigned gen = old / nloc;
        if (old + 1u == (gen + 1u) * nloc) {
            __builtin_amdgcn_fence(__ATOMIC_RELEASE, "agent");
            asm volatile("s_waitcnt vmcnt(0)" ::: "memory");
            const unsigned og = xb_add(&bar[XB_TOP], 1u);
            const unsigned tg = og / nx;
            if (og + 1u == (tg + 1u) * nx) xb_add(&bar[XB_TOPGEN], 1u);
            else XB_SPIN(xb_ld(&bar[XB_TOPGEN]) == tg, bar);
            __builtin_amdgcn_fence(__ATOMIC_ACQUIRE, "agent");
            xb_add(&bar[XB_XGEN(b.x)], 1u);
            asm volatile("s_waitcnt vmcnt(0)" ::: "memory");
        } else {
            XB_SPIN(xb_ld(&bar[XB_XGEN(b.x)]) == gen, bar);
            __builtin_amdgcn_fence(__ATOMIC_ACQUIRE, "agent");
            asm volatile("s_waitcnt vmcnt(0)" ::: "memory");
        }
    }
    __syncthreads();
}

__global__ void __launch_bounds__(NT) fwd_megakernel(Params p) {
  __shared__ __attribute__((aligned(16))) char smem[160 * 1024];
  cg::grid_group grid = cg::this_grid();
  char* ws = p.ws;
  const int nb = gridDim.x, bid = blockIdx.x;
  int rot = 0;
  volatile XLAS unsigned* xst = (volatile XLAS unsigned*)(smem + 163824);
  if (tid_() == 0) { xst[0] = 0u; xst[1] = 0u; xst[2] = 0u; xst[3] = 0u; }
  __syncthreads();
  const XcdBarrier xb = xcd_barrier_post((unsigned*)(ws + OFF_BAR), xst);
  if (p.pos == nullptr) grid.sync();
  phase_prep(p, smem);
  xcd_barrier(xb);
  { EpiProj0 E; E.O = (u16*)(ws + OFF_PROJ0); pg8_run((const u16*)(ws + OFF_XB), 1024, (const u16*)(ws + OFF_W1T), 2048, 1024, E, smem); }
  xcd_barrier(xb);
  {
    RgPre pre;
    int it = (bid + nb - rot) % nb;
    if (it < 2048) rglru_load(p, it, pre);
    for (; it < 2048; it += nb) rglru_item(p, it, (it + nb < 2048) ? it + nb : -1, pre, smem);
  }
  rot = (rot + 2048) % nb;
  gemm_phase<2>(p, (const u16*)(ws + OFF_PROJ0) + 1536, LD0, (const u16*)(ws + OFF_WQT), 256, 768, rot, smem);
  gemm_phase<3>(p, (const u16*)(ws + OFF_PROJ0) + 1792, LD0, (const u16*)(ws + OFF_WKVT), 128, 1024, rot, smem);
  for (int it = (bid + nb - rot) % nb; it < 128; it += nb) krope_item(p, it);
  rot = (rot + 128) % nb;
  xcd_barrier(xb);
  for (int it = bid; it < 1024; it += nb) {
    const int j = it & 255, i = it >> 8, g = j >> 6, bh = j & 63;
    const int qb = (i == 0) ? 15 - g : (i == 1) ? 8 + g : (i == 2) ? 7 - g : g;
    attn_item(p, bh, qb, smem);
  }
  for (int it = bid; it < 256; it += nb) fixup_item(p, it, smem);
  xcd_barrier(xb);
  rot = 0;
  { EpiResid<false> E; E.src = p.x; E.dst = p.out; E.ss = nullptr; E.lds_tbl = nullptr; pg8_run((const u16*)(ws + OFF_YCAT), 1024, (const u16*)(ws + OFF_WOT), 1024, 1024, E, smem); }
  xcd_barrier(xb);
  ln_phase(p, p.ab_ln_g, p.ab_ln_b, (u16*)(ws + OFF_X1B));
  xcd_barrier(xb);
  rot = 0;
  { EpiProj1 E; E.Z = (u16*)(ws + OFF_Z); E.X = (u16*)(ws + OFF_XBC); E.H = (u16*)(ws + OFF_HALO); E.dt = (float*)(ws + OFF_DT); pg8_run((const u16*)(ws + OFF_X1B), 1024, (const u16*)(ws + OFF_W2T), 5376, 1024, E, smem); }
  xcd_barrier(xb);
  ssdprep_phase(p);
  xcd_barrier(xb);
  for (int it = bid; it < 256; it += nb) {
    const int x = it & 7, slot = it >> 3, grp = x * 4 + (slot >> 3);
    ssd_item(p, (grp >> 2) * 32 + (grp & 3) * 8 + (slot & 7), smem);
  }
  xcd_barrier(xb);
  rot = 0;
  { EpiResid<true> E; E.src = p.out; E.dst = p.out; E.ss = (const float*)(ws + OFF_SS); E.lds_tbl = smem + 131072; pg8_run((const u16*)(ws + OFF_Z), 2048, (const u16*)(ws + OFF_W3T), 1024, 2048, E, smem); }
  xcd_barrier(xb);
  ln_phase(p, p.ssd_ln_g, p.ssd_ln_b, nullptr);
}

extern "C" void kernel_launch(void* const* d_in, const int* in_sizes, int n_in, void* d_out, int out_size, void* d_ws, size_t ws_size, hipStream_t stream) {
  static int grid_blocks = 0;
  if (!grid_blocks) {
    int dev = 0, cus = 0, per_cu = 0;
    hipGetDevice(&dev);
    hipDeviceGetAttribute(&cus, hipDeviceAttributeMultiprocessorCount, dev);
    hipOccupancyMaxActiveBlocksPerMultiprocessor(&per_cu, fwd_megakernel, NT, 0);
    if (per_cu < 1) per_cu = 1;
    grid_blocks = cus * per_cu;
  }
  Params p{};
  p.x = (const float*)d_in[0]; p.pos = (const int*)d_in[1];
  p.ab_w_in = (const float*)d_in[2]; p.ab_conv_w = (const float*)d_in[3]; p.ab_conv_b = (const float*)d_in[4];
  p.ga_w = (const float*)d_in[5]; p.ga_b = (const float*)d_in[6]; p.gx_w = (const float*)d_in[7]; p.gx_b = (const float*)d_in[8];
  p.lam = (const float*)d_in[9]; p.qn = (const float*)d_in[10]; p.kvn = (const float*)d_in[11]; p.w_uq = (const float*)d_in[12];
  p.w_ukv = (const float*)d_in[13]; p.ab_w_out = (const float*)d_in[14]; p.ab_ln_g = (const float*)d_in[15]; p.ab_ln_b = (const float*)d_in[16];
  p.ssd_w_in = (const float*)d_in[17]; p.ssd_conv_w = (const float*)d_in[18]; p.ssd_conv_b = (const float*)d_in[19]; p.dt_bias = (const float*)d_in[20];
  p.a_log = (const float*)d_in[21]; p.ssd_d = (const float*)d_in[22]; p.ssd_norm = (const float*)d_in[23]; p.ssd_w_out = (const float*)d_in[24];
  p.ssd_ln_g = (const float*)d_in[25]; p.ssd_ln_b = (const float*)d_in[26];
  p.out = (float*)d_out; p.ws = (char*)d_ws;
  hipMemsetAsync((char*)d_ws + OFF_BAR, 0, XCD_BAR_WORDS * sizeof(unsigned), stream);
  void* args[] = {&p};
  hipError_t e = hipLaunchCooperativeKernel((void*)fwd_megakernel, dim3(grid_blocks), dim3(NT), args, 0, stream);
  if (e != hipSuccess) fprintf(stderr, "cooperative launch failed: %s (grid %d)\n", hipGetErrorString(e), grid_blocks);
}
```
